# Optimizing an MI355X kernel written in HIP

```python
import math
import jax, jax.numpy as jnp
from jax import lax
import numpy as np

D_MODEL = 1024
BATCH = 2
SEQ = 8192
DEPTH = 1

CHUNK = 64
Q_BLOCK = 128
FOX_HEADS = 8
FOX_HEAD_DIM = 64
FOX_WIDTH = FOX_HEADS * FOX_HEAD_DIM
DIFF_HEADS = 4
DIFF_HEAD_DIM = 64
DIFF_V_DIM = 2 * DIFF_HEAD_DIM
DIFF_WIDTH = DIFF_HEADS * DIFF_V_DIM
N_BRANCH = 2
IN_COLS = 3 * FOX_WIDTH + FOX_HEADS + 3 * DIFF_WIDTH + N_BRANCH * D_MODEL
N_GROUPS = 4
EXPERTS_PER_GROUP = 8
N_EXPERTS = N_GROUPS * EXPERTS_PER_GROUP
TOP_K_EXPERT = 2
D_EXPERT = D_MODEL // 2
MOE_BLOCK = 128
EPS = 1e-6

kernel_name = "fox_diffattn_hiermoe_hybrid_block"


def rms_norm(x, g):
    xf = x.astype(jnp.float32)
    y = xf * lax.rsqrt(jnp.mean(xf * xf, axis=-1, keepdims=True) + EPS)
    return (y * g.astype(jnp.float32)).astype(x.dtype)


def to_heads(t, n_heads):
    b, s, _ = t.shape
    return t.reshape(b, s, n_heads, -1).transpose(0, 2, 1, 3)


def from_heads(t):
    b, h, s, d = t.shape
    return t.transpose(0, 2, 1, 3).reshape(b, s, h * d)


def fox_attention(q, k, v, log_f):
    B, H, S, d = q.shape
    F = jnp.cumsum(log_f, axis=-1)
    pos = jnp.arange(S)
    scale = d ** -0.5

    def block(i):
        start = i * Q_BLOCK
        qb = lax.dynamic_slice_in_dim(q, start, Q_BLOCK, axis=2)
        Fq = lax.dynamic_slice_in_dim(F, start, Q_BLOCK, axis=2)
        tq = start + jnp.arange(Q_BLOCK)
        s = jnp.einsum('bhqd,bhkd->bhqk', qb, k, preferred_element_type=jnp.float32) * scale
        s = s + Fq[..., :, None] - F[..., None, :]
        mask = pos[None, :] <= tq[:, None]
        s = jnp.where(mask, s, -jnp.inf)
        p = jax.nn.softmax(s, axis=-1).astype(v.dtype)
        return jnp.einsum('bhqk,bhkd->bhqd', p, v)

    out = lax.map(block, jnp.arange(S // Q_BLOCK))
    return out.transpose(1, 2, 0, 3, 4).reshape(B, H, S, d)


def diff_attention(q1, q2, k1, k2, v, lam, slopes):
    B, H, S, d = q1.shape
    pos = jnp.arange(S)
    chunk_k = pos // CHUNK
    scale = d ** -0.5

    def block(i):
        start = i * Q_BLOCK
        q1b = lax.dynamic_slice_in_dim(q1, start, Q_BLOCK, axis=2)
        q2b = lax.dynamic_slice_in_dim(q2, start, Q_BLOCK, axis=2)
        tq = start + jnp.arange(Q_BLOCK)
        dist = jnp.abs(tq[:, None] - pos[None, :]).astype(jnp.float32)
        bias = -slopes[:, None, None] * dist
        mask = chunk_k[None, :] <= (tq // CHUNK)[:, None]
        s1 = jnp.einsum('bhqd,bhkd->bhqk', q1b, k1, preferred_element_type=jnp.float32) * scale + bias
        s2 = jnp.einsum('bhqd,bhkd->bhqk', q2b, k2, preferred_element_type=jnp.float32) * scale + bias
        p1 = jax.nn.softmax(jnp.where(mask, s1, -jnp.inf), axis=-1)
        p2 = jax.nn.softmax(jnp.where(mask, s2, -jnp.inf), axis=-1)
        a = (p1 - lam * p2).astype(v.dtype)
        return jnp.einsum('bhqk,bhkd->bhqd', a, v)

    out = lax.map(block, jnp.arange(S // Q_BLOCK))
    return out.transpose(1, 2, 0, 3, 4).reshape(B, H, S, v.shape[-1])


def hybrid_mixer(h, w_in, b_fgate, b_gate, lq1, lk1, lq2, lk2, g_subln, w_pa, w_pb, w_o, lam_init):
    z = h @ w_in
    widths = [FOX_WIDTH] * 3 + [FOX_HEADS] + [DIFF_WIDTH] * 3 + [D_MODEL] * N_BRANCH
    splits = [int(c) for c in np.cumsum(widths)[:-1]]
    fq, fk, fv, ff, dq, dk, dv, ga, gb = jnp.split(z, splits, axis=-1)

    log_f = jax.nn.log_sigmoid((ff + b_fgate).astype(jnp.float32)).transpose(0, 2, 1)
    o_a = from_heads(fox_attention(to_heads(fq, FOX_HEADS), to_heads(fk, FOX_HEADS),
                                   to_heads(fv, FOX_HEADS), log_f))

    qh = to_heads(dq, DIFF_HEADS)
    kh = to_heads(dk, DIFF_HEADS)
    vh = to_heads(dv, DIFF_HEADS)
    q1, q2 = qh[..., :DIFF_HEAD_DIM], qh[..., DIFF_HEAD_DIM:]
    k1, k2 = kh[..., :DIFF_HEAD_DIM], kh[..., DIFF_HEAD_DIM:]
    f32 = jnp.float32
    lam = (jnp.exp(jnp.sum(lq1.astype(f32) * lk1.astype(f32)))
           - jnp.exp(jnp.sum(lq2.astype(f32) * lk2.astype(f32))) + lam_init)
    slopes = jnp.exp2(-8.0 / DIFF_HEADS * jnp.arange(1, DIFF_HEADS + 1, dtype=f32))
    ob = diff_attention(q1, q2, k1, k2, vh, lam, slopes)
    ob = rms_norm(ob, g_subln) * (1.0 - lam_init)
    o_b = from_heads(ob)

    gate_a = jax.nn.sigmoid(ga + b_gate[:D_MODEL])
    gate_b = jax.nn.sigmoid(gb + b_gate[D_MODEL:])
    y = gate_a * (o_a @ w_pa) + gate_b * (o_b @ w_pb)
    return y @ w_o


def hier_moe(h, w_group, b_group, w_expert, b_expert, w1, w3, w2):
    B, S, D = h.shape
    N = B * S
    hf = h.reshape(N, D)
    f32 = jnp.float32
    gl = (hf @ w_group).astype(f32) + b_group.astype(f32)
    gp = jax.nn.softmax(gl, axis=-1)
    g_idx = jnp.argmax(gl, axis=-1)
    g_w = jnp.take_along_axis(gp, g_idx[:, None], axis=-1)[:, 0]
    el = (hf @ w_expert).astype(f32).reshape(N, N_GROUPS, EXPERTS_PER_GROUP)
    el = jnp.take_along_axis(el, g_idx[:, None, None], axis=1)[:, 0] + b_expert.astype(f32)[g_idx]
    ep = jax.nn.softmax(el, axis=-1)
    vals, idx = lax.top_k(ep, TOP_K_EXPERT)
    vals = vals / jnp.sum(vals, axis=-1, keepdims=True)
    weights = g_w[:, None] * vals
    expert_ids = (g_idx[:, None] * EXPERTS_PER_GROUP + idx).astype(jnp.int32)

    A = N * TOP_K_EXPERT
    e_flat = expert_ids.reshape(A)
    w_flat = weights.reshape(A)
    tok = jnp.repeat(jnp.arange(N, dtype=jnp.int32), TOP_K_EXPERT)
    order = jnp.argsort(e_flat)
    e_s, tok_s, w_s = e_flat[order], tok[order], w_flat[order]
    counts = jnp.bincount(e_flat, length=N_EXPERTS)
    padded = (counts + MOE_BLOCK - 1) // MOE_BLOCK * MOE_BLOCK
    start = jnp.cumsum(counts) - counts
    pstart = jnp.cumsum(padded) - padded
    dest = pstart[e_s] + jnp.arange(A) - start[e_s]
    P = A + N_EXPERTS * MOE_BLOCK
    n_blk = P // MOE_BLOCK
    row_tok = jnp.zeros((P,), jnp.int32).at[dest].set(tok_s)
    row_w = jnp.zeros((P,), f32).at[dest].set(w_s)
    blk_e = jnp.searchsorted(jnp.cumsum(padded), jnp.arange(n_blk) * MOE_BLOCK, side='right')
    blk_e = jnp.minimum(blk_e, N_EXPERTS - 1)
    xb = hf[row_tok].reshape(n_blk, MOE_BLOCK, D)

    def expert_block(args):
        xblk, e = args
        return (jax.nn.silu(xblk @ w1[e]) * (xblk @ w3[e])) @ w2[e]

    yb = lax.map(expert_block, (xb, blk_e)).reshape(P, D)
    out = jnp.zeros_like(hf).at[row_tok].add(yb * row_w[:, None].astype(yb.dtype))
    return out.reshape(B, S, D)


def setup_inputs(seed: int = 0) -> dict:
    key = jax.random.key(seed)
    ks = jax.random.split(key, 24)
    n = jax.random.normal
    f = jnp.float32
    L = DEPTH
    return {
        "x": n(ks[0], (BATCH, SEQ, D_MODEL), f),
        "g_mix": 1.0 + 0.01 * n(ks[1], (L, D_MODEL), f),
        "w_in": n(ks[2], (L, D_MODEL, IN_COLS), f) * D_MODEL ** -0.5,
        "b_fgate": 1.0 + 0.5 * n(ks[3], (L, FOX_HEADS), f),
        "b_gate": 0.1 * n(ks[4], (L, N_BRANCH * D_MODEL), f),
        "lam_q1": 0.1 * n(ks[5], (L, DIFF_HEAD_DIM), f),
        "lam_k1": 0.1 * n(ks[6], (L, DIFF_HEAD_DIM), f),
        "lam_q2": 0.1 * n(ks[7], (L, DIFF_HEAD_DIM), f),
        "lam_k2": 0.1 * n(ks[8], (L, DIFF_HEAD_DIM), f),
        "g_subln": 1.0 + 0.01 * n(ks[9], (L, DIFF_V_DIM), f),
        "w_pa": n(ks[10], (L, FOX_WIDTH, D_MODEL), f) * FOX_WIDTH ** -0.5,
        "w_pb": n(ks[11], (L, DIFF_WIDTH, D_MODEL), f) * DIFF_WIDTH ** -0.5,
        "w_o": n(ks[12], (L, D_MODEL, D_MODEL), f) * D_MODEL ** -0.5,
        "g_moe": 1.0 + 0.01 * n(ks[13], (L, D_MODEL), f),
        "w_group": n(ks[14], (L, D_MODEL, N_GROUPS), f) * D_MODEL ** -0.5,
        "b_group": 0.01 * n(ks[15], (L, N_GROUPS), f),
        "w_expert": n(ks[16], (L, D_MODEL, N_EXPERTS), f) * D_MODEL ** -0.5,
        "b_expert": 0.01 * n(ks[17], (L, N_GROUPS, EXPERTS_PER_GROUP), f),
        "w1": n(ks[18], (L, N_EXPERTS, D_MODEL, D_EXPERT), f) * D_MODEL ** -0.5,
        "w3": n(ks[19], (L, N_EXPERTS, D_MODEL, D_EXPERT), f) * D_MODEL ** -0.5,
        "w2": n(ks[20], (L, N_EXPERTS, D_EXPERT, D_MODEL), f) * D_EXPERT ** -0.5,
        "g_final": 1.0 + 0.01 * n(ks[21], (D_MODEL,), f),
    }


def reference(x, g_mix, w_in, b_fgate, b_gate, lam_q1, lam_k1, lam_q2, lam_k2, g_subln,
              w_pa, w_pb, w_o, g_moe, w_group, b_group, w_expert, b_expert, w1, w3, w2, g_final):
    for l in range(DEPTH):
        lam_init = 0.8 - 0.6 * math.exp(-0.3 * l)
        h = rms_norm(x, g_mix[l])
        x = x + hybrid_mixer(h, w_in[l], b_fgate[l], b_gate[l], lam_q1[l], lam_k1[l],
                             lam_q2[l], lam_k2[l], g_subln[l], w_pa[l], w_pb[l], w_o[l], lam_init)
        h = rms_norm(x, g_moe[l])
        x = x + hier_moe(h, w_group[l], b_group[l], w_expert[l], b_expert[l], w1[l], w3[l], w2[l])
    return rms_norm(x, g_final)
```

```cpp
#include <hip/hip_runtime.h>
#include <cstdio>
#include <cstdint>

#define LAS __attribute__((address_space(3)))
#define GAS __attribute__((address_space(1)))
typedef unsigned short bf16_t;
typedef short bf16x8 __attribute__((ext_vector_type(8)));
typedef short s16x4 __attribute__((ext_vector_type(4)));
typedef float f32x4 __attribute__((ext_vector_type(4)));
typedef float f32x2 __attribute__((ext_vector_type(2)));
typedef float f32x16 __attribute__((ext_vector_type(16)));
typedef unsigned u32x4 __attribute__((ext_vector_type(4)));
typedef unsigned u32x2 __attribute__((ext_vector_type(2)));
typedef GAS unsigned gu32;

#ifndef MK_N_LAUNCHES
#define MK_N_LAUNCHES 1
#define DBG_NTILES 128
#define DBG_SELH 0x40
#define DBG_SELR 0x3fff
#endif

constexpr int BATCH = 2, SEQ = 8192, DM = 1024, M = BATCH * SEQ;
constexpr int NPROJ = 5120;
constexpr int NEXP = 32, DEXP = 512;
constexpr float EPS = 1e-6f;
constexpr float LOG2E = 1.4426950408889634f;
constexpr float C2 = 0.125f * LOG2E;
constexpr float SKIP_T = 40.0f;
constexpr int SEG = 32;
constexpr float LAM_INIT = 0.2f;

constexpr size_t MiB = 1u << 20;
constexpr size_t WS_CTL = 0, CTL_ZERO_BYTES = 1 * MiB;
constexpr size_t WS_MISC = 1 * MiB;
constexpr size_t WS_WIN = 4 * MiB, WS_WPA = 14 * MiB, WS_WPB = 15 * MiB, WS_WO = 16 * MiB;
constexpr size_t WS_C = 18 * MiB;
constexpr size_t WS_D = 50 * MiB;
constexpr size_t WS_E = 146 * MiB;
constexpr size_t WS_END = 242 * MiB;
constexpr size_t WS_OA = WS_C, WS_OB = WS_C + 16 * MiB;
constexpr size_t QKV_STRIDE = 16 * MiB;
constexpr size_t WS_UP = WS_D, WS_DN = WS_D + 64 * MiB, WS_YEXP = WS_D;
constexpr size_t WS_Y = WS_E, WS_X1 = WS_E + 32 * MiB;
constexpr size_t PART_SLOT = 8 * 64 * 64 * 4 + 8 * 32 * 8;
constexpr size_t MS_LF = 0;
constexpr size_t MS_FB = 512 * 1024;
constexpr size_t MS_UNITS = 1024 * 1024;
constexpr size_t MS_ASG = MS_UNITS + 16384;
constexpr size_t MS_HIST = MS_ASG + 3 * M * 8;
constexpr size_t MS_ROWTOK = MS_HIST + 256 * 32 * 4;
constexpr size_t MS_ROWDST = MS_ROWTOK + 40960 * 4;
constexpr size_t MS_ROWW = MS_ROWDST + 40960 * 4;
constexpr size_t MS_TILEE = MS_ROWW + 40960 * 4;
static_assert(MS_TILEE + 1024 <= 3 * MiB, "misc region");
constexpr int CW_QHEAD = 64, CW_NUNITS = 128, CW_KMAX = 192  , CW_BAR = 4096;

constexpr int RING_OFF = 0, RING_BYTES = 131072;
constexpr int L_FBT = 98304;
constexpr int L_WSF = 131072;
constexpr int L_AUX = 139264;
constexpr int MISC_OFF = 147456;
constexpr int LDS_BYTES = 147456 + 512;
constexpr int NWAVES = 8;

#define RLX_AGENT __ATOMIC_RELAXED, __HIP_MEMORY_SCOPE_AGENT
#define LDS_WAIT() asm volatile("s_waitcnt lgkmcnt(0)" ::: "memory")
#define VM_WAIT() asm volatile("s_waitcnt vmcnt(0)" ::: "memory")
#define SBAR() __builtin_amdgcn_sched_barrier(0)

__device__ __forceinline__ unsigned f2bf(float f) { unsigned u = __builtin_bit_cast(unsigned, f); return (u + 0x7fffu + ((u >> 16) & 1u)) >> 16; }
__device__ __forceinline__ unsigned pk2(float lo, float hi) { return f2bf(lo) | (f2bf(hi) << 16); }
typedef __bf16 bf16x2_t __attribute__((ext_vector_type(2)));
__device__ __forceinline__ unsigned cvtpk_s(float lo, float hi) { f32x2 v = {lo, hi}; bf16x2_t b = __builtin_convertvector(v, bf16x2_t); return __builtin_bit_cast(unsigned, b); }
__device__ __forceinline__ unsigned cvt_pk_bf16(float lo, float hi) { return cvtpk_s(lo, hi); }
__device__ __forceinline__ float bf_lo(unsigned w) { return __builtin_bit_cast(float, w << 16); }
__device__ __forceinline__ float bf_hi(unsigned w) { return __builtin_bit_cast(float, w & 0xffff0000u); }
__device__ __forceinline__ float fsigmoid(float x) { return __builtin_amdgcn_rcpf(1.0f + __builtin_amdgcn_exp2f(-x * LOG2E)); }
__device__ __forceinline__ float wave_sum(float v) {
#pragma unroll
    for (int o = 1; o < 64; o <<= 1) v += __shfl_xor(v, o);
    return v;
}
__device__ __forceinline__ float wave_max(float v) {
#pragma unroll
    for (int o = 1; o < 64; o <<= 1) v = fmaxf(v, __shfl_xor(v, o));
    return v;
}
__device__ __forceinline__ void glds16(const void* gsrc, unsigned lds_dst) { unsigned keep;
    asm volatile("s_mov_b32 %0, m0\n\ts_mov_b32 m0, %2\n\ts_nop 0\n\tglobal_load_lds_dwordx4 %1, off\n\ts_mov_b32 m0, %0" : "=&s"(keep) : "v"(gsrc), "s"(lds_dst) : "memory"); }

namespace pg8 {
constexpr int BM = 256, BK = 64, HALF = 128, HTB = HALF * BK * 2, NXCD = 8, WGM = 8;
__host__ __device__ __forceinline__ int lds_byte(int r, int c) { const int st = (r >> 4) * 2 + (c >> 5), rr = r & 15, cc = c & 31, ob = rr * 64 + cc * 2; return st * 1024 + (ob ^ (((ob >> 9) & 1) << 5)); }
__host__ __device__ __forceinline__ void stage_rc(int b, int& R, int& C) { const int st = b / 1024, sb = b % 1024, swz = sb ^ (((sb >> 9) & 1) << 5); R = (st >> 1) * 16 + swz / 64; C = (st & 1) * 32 + (swz % 64) / 2; }
__host__ __device__ __forceinline__ int perm32(int rho) { const int n = rho >> 4, i = rho & 15; return 8 * (i >> 2) + 4 * n + (i & 3); }
struct Unit { int pm, pn, aux; };
struct StaticOrder {
    int nM, nN, nwg, G, c;
    __device__ void init(int M_, int N_, int G_, int c_) { nM = M_ / BM; nN = N_ / BM; nwg = nM * nN; G = G_; c = c_; }
    __device__ bool next(int i, Unit& u) const {
        const long L = (long)i * G + c; if (L >= nwg) return false;
        int wgid = (int)L; { const int q = nwg / NXCD, r = nwg % NXCD, xcd = wgid % NXCD, off = wgid / NXCD; wgid = (xcd < r ? xcd * (q + 1) : r * (q + 1) + (xcd - r) * q) + off; }
        const int nig = WGM * nN, gid = wgid / nig, fm = gid * WGM, gsz = (nM - fm) < WGM ? (nM - fm) : WGM;
        u.pm = fm + ((wgid % nig) % gsz); u.pn = (wgid % nig) / gsz; u.aux = 0; return true;
    }
};
typedef f32x4 Acc[2][2][4][2];
template <class P>
__device__ __forceinline__ void gemm_run(LAS unsigned char* lds, const P& S) {
    const int tid = threadIdx.x, wid = __builtin_amdgcn_readfirstlane(tid >> 6), lane = tid & 63, wr = wid >> 2, wc = wid & 3, fr = lane & 15, fq = lane >> 4;
    const int K = S.K, nt = K / BK;
    int rA[2], cA2[2]; unsigned voffB[2];
#pragma unroll
    for (int i = 0; i < 2; ++i) { int R, C; stage_rc(tid * 16 + i * 8192, R, C); const int Rb = P::PERM ? ((R & ~31) + perm32(R & 31)) : R;
        rA[i] = R; cA2[i] = C * 2; voffB[i] = (unsigned)(Rb * K + C) * 2u; }
    const size_t kstep = (size_t)(BK * 2);
    const size_t hstepB = (size_t)HALF * K * 2;
    const unsigned ldsw = (unsigned)wid * 1024u;
    const int aoff = lds_byte(wr * 64 + fr, fq * 8), boff = lds_byte(wc * 32 + fr, fq * 8);
#define PG8_SA(b, h) (((b) * 2 + (h)) * HTB)
#define PG8_SB(b, h) ((4 + (b) * 2 + (h)) * HTB)
#define PG8_STAGE(bufoff, gbase, voff) do { _Pragma("unroll") for (int _i = 0; _i < 2; ++_i) \
        __builtin_amdgcn_global_load_lds((const unsigned*)((const char*)(gbase) + (voff)[_i]), (LAS unsigned*)(lds + (bufoff) + ldsw + _i * 8192), 16, 0, 0); } while (0)
#define PG8_LDA(dst, b, h) do { _Pragma("unroll") for (int m = 0; m < 4; ++m) _Pragma("unroll") for (int k = 0; k < 2; ++k) dst[m][k] = *(const LAS bf16x8*)(lds + PG8_SA(b, h) + aoff + m * 2048 + k * 1024); } while (0)
#define PG8_LDB(dst, b, h) do { _Pragma("unroll") for (int n = 0; n < 2; ++n) _Pragma("unroll") for (int k = 0; k < 2; ++k) dst[n][k] = *(const LAS bf16x8*)(lds + PG8_SB(b, h) + boff + n * 2048 + k * 1024); } while (0)
#define PG8_MMA(ai, bj, At, Bt) do { __builtin_amdgcn_s_setprio(1); _Pragma("unroll") for (int m = 0; m < 4; ++m) _Pragma("unroll") for (int n = 0; n < 2; ++n) _Pragma("unroll") for (int k = 0; k < 2; ++k) \
        acc[ai][bj][m][n] = __builtin_amdgcn_mfma_f32_16x16x32_bf16(Bt[n][k], At[m][k], acc[ai][bj][m][n], 0, 0, 0); __builtin_amdgcn_s_setprio(0); } while (0)
#define PG8_WAIT_V(n) asm volatile("s_waitcnt vmcnt(" #n ")" ::: "memory")
#define PG8_WAIT_L(n) asm volatile("s_waitcnt lgkmcnt(" #n ")" ::: "memory")
#define PG8_BAR __builtin_amdgcn_s_barrier()
#define PG8_SCHED __builtin_amdgcn_sched_barrier(0)
#define PG8_ZERO() do { _Pragma("unroll") for (int a = 0; a < 2; ++a) _Pragma("unroll") for (int b = 0; b < 2; ++b) _Pragma("unroll") for (int m = 0; m < 4; ++m) _Pragma("unroll") for (int n = 0; n < 2; ++n) acc[a][b][m][n] = (f32x4){0.f, 0.f, 0.f, 0.f}; } while (0)
    Unit cur, nxt; int ui = 0;
    if (!S.next(0, cur)) return;
    Acc acc; PG8_ZERO();
    bf16x8 At[4][2], B0[2][2], B1[2][2];
    unsigned vA0[2], vA1[2], nA0[2], nA1[2];
    S.a_off(cur, rA, cA2, vA0, vA1);
    const char* cA = S.a_ptr(cur); const char* cB = S.b_ptr(cur);
    PG8_STAGE(PG8_SB(0, 0), cB, voffB); PG8_STAGE(PG8_SB(0, 1), cB + hstepB, voffB); PG8_STAGE(PG8_SA(0, 0), cA, vA0); PG8_STAGE(PG8_SA(0, 1), cA, vA1);
    if (wr == 1) PG8_BAR;
    PG8_WAIT_V(2); PG8_BAR;
    PG8_STAGE(PG8_SB(1, 0), cB + kstep, voffB); PG8_STAGE(PG8_SA(1, 0), cA + kstep, vA0); PG8_STAGE(PG8_SB(1, 1), cB + hstepB + kstep, voffB);
    PG8_WAIT_V(6); PG8_BAR;
    for (;;) {
        const bool has_next = S.next(ui + 1, nxt);
        const char* nA = cA; const char* nB = cB;
        nA0[0] = vA0[0]; nA0[1] = vA0[1]; nA1[0] = vA1[0]; nA1[1] = vA1[1];
        if (has_next) { nA = S.a_ptr(nxt); nB = S.b_ptr(nxt); S.a_off(nxt, rA, cA2, nA0, nA1); }
        for (int t = 0; t < nt; t += 2) {
            const bool last = (t == nt - 2);
            const char* a1 = cA + (size_t)(t + 1) * kstep;
            const char* a2 = last ? nA : cA + (size_t)(t + 2) * kstep; const char* b2 = last ? nB : cB + (size_t)(t + 2) * kstep;
            const char* a3 = a2 + kstep; const char* b3 = b2 + kstep;
            unsigned w0[2], w1[2];
            w0[0] = last ? nA0[0] : vA0[0]; w0[1] = last ? nA0[1] : vA0[1]; w1[0] = last ? nA1[0] : vA1[0]; w1[1] = last ? nA1[1] : vA1[1];
            PG8_LDB(B0, 0, 0); PG8_LDB(B1, 0, 1); PG8_SCHED; PG8_LDA(At, 0, 0); PG8_STAGE(PG8_SA(1, 1), a1, vA1);
            PG8_WAIT_V(8); PG8_WAIT_L(0); PG8_BAR; PG8_MMA(0, 0, At, B0); PG8_MMA(0, 1, At, B1); PG8_BAR; PG8_SCHED;
            PG8_LDA(At, 0, 1); PG8_STAGE(PG8_SB(0, 0), b2, voffB); PG8_STAGE(PG8_SB(0, 1), b2 + hstepB, voffB); PG8_STAGE(PG8_SA(0, 0), a2, w0);
            PG8_WAIT_V(8); PG8_WAIT_L(0); PG8_BAR; PG8_MMA(1, 0, At, B0); PG8_MMA(1, 1, At, B1); PG8_BAR; PG8_SCHED;
            PG8_LDB(B0, 1, 0); PG8_LDB(B1, 1, 1); PG8_SCHED; PG8_LDA(At, 1, 0); PG8_STAGE(PG8_SA(0, 1), a2, w1);
            PG8_WAIT_V(8); PG8_WAIT_L(0); PG8_BAR; PG8_MMA(0, 0, At, B0); PG8_MMA(0, 1, At, B1); PG8_BAR; PG8_SCHED;
            PG8_LDA(At, 1, 1); PG8_STAGE(PG8_SB(1, 0), b3, voffB); PG8_STAGE(PG8_SB(1, 1), b3 + hstepB, voffB); PG8_STAGE(PG8_SA(1, 0), a3, w0);
            PG8_WAIT_V(8); PG8_WAIT_L(0); PG8_BAR; PG8_MMA(1, 0, At, B0); PG8_MMA(1, 1, At, B1); PG8_BAR; PG8_SCHED;
        }
        if (wr == 0) PG8_BAR;
        S.epilogue(acc, cur, wr, wc, fr, fq);
        if (!has_next) break;
        if (!S.keep(cur)) PG8_ZERO();
        cur = nxt; cA = nA; cB = nB; vA0[0] = nA0[0]; vA0[1] = nA0[1]; vA1[0] = nA1[0]; vA1[1] = nA1[1]; ++ui;
        if (wr == 1) PG8_BAR;
    }
    PG8_WAIT_V(0);
    PG8_BAR;
#undef PG8_SA
#undef PG8_SB
#undef PG8_STAGE
#undef PG8_LDA
#undef PG8_LDB
#undef PG8_MMA
#undef PG8_WAIT_V
#undef PG8_WAIT_L
#undef PG8_BAR
#undef PG8_SCHED
#undef PG8_ZERO
}
}

#define XB_TMO      128
#define XB_XCNT(j)  (256  + 64 * (j))
#define XB_XSUB(j)  (1280 + 64 * (j))
#define XB_XGEN(j)  (2304 + 64 * (j))
#define XB_TOP      3328
#define XB_TOPGEN   3392
#define XCD_BAR_WORDS 3456
#define XB_SPIN_CAP (1u << 18)
__device__ __forceinline__ unsigned xb_ld(unsigned* p)              { return __hip_atomic_load(p, __ATOMIC_RELAXED, __HIP_MEMORY_SCOPE_AGENT); }
__device__ __forceinline__ unsigned xb_add(unsigned* p, unsigned v) { return __hip_atomic_fetch_add(p, v, __ATOMIC_RELAXED, __HIP_MEMORY_SCOPE_AGENT); }
__device__ __forceinline__ unsigned xb_xcc_id() { return (unsigned)__builtin_amdgcn_s_getreg((3 << 11) | 20) & 0xFu; }
#define XB_SPIN(cond, bar) do { unsigned _sp = 0; while (cond) { __builtin_amdgcn_s_sleep(1); \
    if ((++_sp & 255u) == 0u) { if (xb_ld(&(bar)[XB_TMO])) break; if (_sp > XB_SPIN_CAP) { atomicAdd(&(bar)[XB_TMO], 1u); break; } } } } while (0)
struct XcdBarrier { unsigned* bar; unsigned x; volatile LAS unsigned* st; };
__device__ __forceinline__ XcdBarrier xcd_barrier_post(unsigned* bar, volatile LAS unsigned* st) {
    XcdBarrier b; b.bar = bar; b.x = xb_xcc_id(); b.st = st;
    if (threadIdx.x == 0) (void)xb_add(&bar[XB_XCNT(b.x)], 1u);
    return b;
}
__device__ __forceinline__ void xcd_barrier_complete(unsigned* bar, unsigned x, unsigned& nloc, unsigned& nx) {
    const unsigned G = gridDim.x * gridDim.y * gridDim.z;
    unsigned sum, cnt, mine, sp = 0u;
    for (;;) {
        sum = 0u; cnt = 0u; mine = 0u;
#pragma unroll
        for (unsigned j = 0; j < 16; ++j) { const unsigned c = xb_ld(&bar[XB_XCNT(j)]); sum += c; cnt += (c > 0u) ? 1u : 0u; mine = (j == x) ? c : mine; }
        if (sum == G) break;
        __builtin_amdgcn_s_sleep(1);
        if ((++sp & 255u) == 0u) { if (xb_ld(&bar[XB_TMO])) break; if (sp > XB_SPIN_CAP) { atomicAdd(&bar[XB_TMO], 1u); break; } }
    }
    nloc = mine > 0u ? mine : 1u; nx = cnt > 0u ? cnt : 1u;
}
__device__ __forceinline__ void xcd_barrier(const XcdBarrier& b) {
    asm volatile("s_waitcnt vmcnt(0)" ::: "memory");
    __syncthreads();
    if (threadIdx.x == 0) {
        unsigned* bar = b.bar;
        __builtin_amdgcn_s_waitcnt(0);
        unsigned nloc = b.st[0], nx = b.st[1];
        if (nloc == 0u) { xcd_barrier_complete(bar, b.x, nloc, nx); b.st[0] = nloc; b.st[1] = nx; }
        const unsigned old = xb_add(&bar[XB_XSUB(b.x)], 1u);
        const unsigned gen = old / nloc;
        if (old + 1u == (gen + 1u) * nloc) {
            __builtin_amdgcn_fence(__ATOMIC_RELEASE, "agent");
            asm volatile("s_waitcnt vmcnt(0)" ::: "memory");
            const unsigned og = xb_add(&bar[XB_TOP], 1u);
            const unsigned tg = og / nx;
            if (og + 1u == (tg + 1u) * nx) xb_add(&bar[XB_TOPGEN], 1u);
            else XB_SPIN(xb_ld(&bar[XB_TOPGEN]) == tg, bar);
            __builtin_amdgcn_fence(__ATOMIC_ACQUIRE, "agent");
            xb_add(&bar[XB_XGEN(b.x)], 1u);
            asm volatile("s_waitcnt vmcnt(0)" ::: "memory");
        } else {
            XB_SPIN(xb_ld(&bar[XB_XGEN(b.x)]) == gen, bar);
            __builtin_amdgcn_fence(__ATOMIC_ACQUIRE, "agent");
            asm volatile("s_waitcnt vmcnt(0)" ::: "memory");
        }
    }
    __syncthreads();
}

struct Args {
    const float* x; const float* g_mix; const float* w_in; const float* b_fgate; const float* b_gate;
    const float* lq1; const float* lk1; const float* lq2; const float* lk2; const float* g_subln;
    const float* w_pa; const float* w_pb; const float* w_o; const float* g_moe; const float* w_group; const float* b_group;
    const float* w_expert; const float* b_expert; const float* w1; const float* w3; const float* w2; const float* g_final;
    float* out; unsigned char* ws; int ph_lo, ph_hi;
};
struct Frame {
    LAS unsigned char* lds; gu32* ctl; unsigned char* ws;
    int tid, lane, wave, vcu, G;
};

__device__ __forceinline__ void transpose_item(const float* src  , int ldn, bf16_t* dst  , int ldk, LAS float* scr, int lane) {
#pragma unroll 8
    for (int i = 0; i < 32; ++i) { const int kk = 2 * i + (lane >> 5); scr[kk * 33 + (lane & 31)] = src[(size_t)kk * ldn + (lane & 31)]; }
    LDS_WAIT(); asm volatile("" ::: "memory");
    const int c = lane & 7;
#pragma unroll
    for (int j = 0; j < 4; ++j) { const int n = (lane >> 3) + 8 * j; const LAS float* s = scr + (8 * c) * 33 + n;
        u32x4 o; o.x = pk2(s[0 * 33], s[1 * 33]); o.y = pk2(s[2 * 33], s[3 * 33]); o.z = pk2(s[4 * 33], s[5 * 33]); o.w = pk2(s[6 * 33], s[7 * 33]);
        *(GAS u32x4*)(dst + (size_t)n * ldk + 8 * c) = o; }
    LDS_WAIT(); asm volatile("" ::: "memory");
}

namespace att {
__device__ __forceinline__ int crow(int r, int hi) { return (r & 3) + 8 * (r >> 2) + 4 * hi; }
typedef LAS const char* lds_cptr;
typedef short v4i16_t __attribute__((ext_vector_type(4)));
__device__ __forceinline__ s16x4 vtr(lds_cptr p) { return __builtin_bit_cast(s16x4, __builtin_amdgcn_ds_read_tr16_b64_v4i16((LAS v4i16_t*)p)); }
__device__ __forceinline__ float partner(float v) { return __shfl_xor(v, 32); }
#define ATT_WAIT_BAR(N) asm volatile("s_waitcnt vmcnt(" #N ") lgkmcnt(0)\n\ts_barrier" ::: "memory")

struct Tensors {
    unsigned char* ws; const float* g_subln; float lam;
    __device__ __forceinline__ const bf16_t* qkv(int t6) const { return (const bf16_t*)(ws + WS_D + (size_t)t6 * QKV_STRIDE); }
    __device__ __forceinline__ bf16_t* oa() const { return (bf16_t*)(ws + WS_OA); }
    __device__ __forceinline__ bf16_t* ob() const { return (bf16_t*)(ws + WS_OB); }
    __device__ __forceinline__ const float* fb() const { return (const float*)(ws + WS_MISC + MS_FB); }
    __device__ __forceinline__ const unsigned* kmax() const { return (const unsigned*)(ws + WS_CTL) + CW_KMAX; }
    __device__ __forceinline__ unsigned char* part() const { return ws + WS_E; }
};

__device__ __forceinline__ void diff_finish(f32x16 (&o)[4], const float (&inv)[16], int wid, int lane_in, LAS char* xch, const Tensors& T, int b, int h, int q0) {
    int lane = lane_in; asm volatile("" : "+v"(lane));
    const int sub = wid & 3, br = wid >> 2, r32 = lane & 31, hi = lane >> 5;
    LAS float* X = (LAS float*)xch + (size_t)sub * 4096;
    if (br == 1) {
#pragma unroll
        for (int g = 0; g < 4; ++g)
#pragma unroll
            for (int r = 0; r < 16; ++r) X[(g * 16 + r) * 64 + lane] = o[g][r] * inv[r] * (-T.lam);
    }
    asm volatile("s_waitcnt lgkmcnt(0)\n\ts_barrier" ::: "memory");
    if (br == 0) {
        float ss[16];
#pragma unroll
        for (int r = 0; r < 16; ++r) ss[r] = 0.f;
#pragma unroll
        for (int g = 0; g < 4; ++g) {
#pragma unroll
            for (int r = 0; r < 16; ++r) { const float v = o[g][r] * inv[r] + X[(g * 16 + r) * 64 + lane]; o[g][r] = v; ss[r] += v * v; }
            asm volatile("" ::: "memory"); }
#pragma unroll
        for (int r = 0; r < 16; ++r) {
            float s = ss[r];
#pragma unroll
            for (int off = 1; off < 32; off <<= 1) s += __shfl_xor(s, off);
            ss[r] = 0.8f * __builtin_amdgcn_rsqf(s * (1.0f / 128.0f) + EPS);
        }
        bf16_t* Ob = T.ob() + ((size_t)b * SEQ + q0 + 32 * sub) * 512 + h * 128;
#pragma unroll
        for (int g = 0; g < 4; ++g) { const float gs = T.g_subln[32 * g + r32];
#pragma unroll
            for (int r = 0; r < 16; ++r) Ob[(size_t)crow(r, hi) * 512 + 32 * g + r32] = (bf16_t)f2bf(o[g][r] * ss[r] * gs); }
    }
}

template <bool DIFF>
__device__ __forceinline__ void attn_unit(const Tensors& T, int b, int h, int qb, int t_lo, int t_hi, bool partial, int slot, LAS char* lds) {
    constexpr int NG = DIFF ? 4 : 2;
    constexpr int KBYTES = DIFF ? 16384 : 8192, STAGE = DIFF ? 32768 : 16384, NPW = DIFF ? 4 : 2;
    int tid_ = threadIdx.x; asm volatile("" : "+v"(tid_));
    const int tid = tid_, lane = tid & 63, r32 = lane & 31, hi = lane >> 5; const int wid = __builtin_amdgcn_readfirstlane(tid >> 6);
    const int sub = DIFF ? (wid & 3) : wid, br = DIFF ? (wid >> 2) : 0;
    const int q0 = DIFF ? qb * 128 : qb * 256;
    const int c_first = q0 >> 6;
    const int c_w = (q0 + 32 * sub) >> 6;
    const int irow = q0 + 32 * sub + r32;
    const size_t rowbase = (size_t)b * SEQ;
    const bf16_t* Qw = T.qkv(DIFF ? 3 : 0) + (rowbase + q0 + 32 * sub) * 512 + (DIFF ? h * 128 + br * 64 : h * 64);
    const bf16_t* Kh = T.qkv(DIFF ? 4 : 1) + rowbase * 512 + (DIFF ? h * 128 : h * 64);
    const bf16_t* Vh = T.qkv(DIFF ? 5 : 2) + rowbase * 512 + (DIFF ? h * 128 : h * 64);
    const unsigned lds0 = (unsigned)(uintptr_t)lds;
    LAS float* wsf = (LAS float*)(lds + L_WSF) + wid * 64;
    LAS float* needs = (LAS float*)(lds + L_AUX);
    const float sl2 = DIFF ? LOG2E * __builtin_amdgcn_exp2f(-2.0f * (float)(h + 1)) : 0.f;
    const bf16_t* ksrc0 = Kh + (size_t)lane * 512 + wid * 8;
    const bf16_t* vsrc0 = Vh + (size_t)(16 * (wid & 3) + (lane >> 2)) * 512 + (wid >> 2) * 32 + (lane & 3) * 8;
#define ATT_ISSUE(t, so) do { const size_t ko_ = (size_t)(t) * 64 * 512; \
        glds16(ksrc0 + ko_, (unsigned)__builtin_amdgcn_readfirstlane(lds0 + (so) + wid * 1024)); \
        glds16(vsrc0 + ko_, (unsigned)__builtin_amdgcn_readfirstlane(lds0 + (so) + KBYTES + wid * 1024)); \
        if (DIFF) { glds16(ksrc0 + ko_ + 64, (unsigned)__builtin_amdgcn_readfirstlane(lds0 + (so) + (wid + 8) * 1024)); \
                    glds16(vsrc0 + ko_ + 64, (unsigned)__builtin_amdgcn_readfirstlane(lds0 + (so) + KBYTES + (wid + 8) * 1024)); } } while (0)
    if (!DIFF) {
        const float* fb = T.fb() + (size_t)(b * 8 + h) * SEQ; LAS float* fbt = (LAS float*)(lds + L_FBT);
        const int nk4 = 16 * (t_hi + 1);
#pragma unroll 1
        for (int i = tid; i < nk4; i += 512) *(LAS f32x4*)(fbt + 4 * i) = *(const f32x4*)(fb + 4 * i);
    }
    const int nsteps = t_hi - t_lo + 1;
    ATT_ISSUE(t_hi, 0);
    if (nsteps > 1) ATT_ISSUE(t_hi - 1, STAGE);
    bf16x8 qr[4];
#pragma unroll
    for (int d0 = 0; d0 < 4; ++d0) qr[d0] = *reinterpret_cast<const bf16x8*>(&Qw[(size_t)r32 * 512 + d0 * 16 + hi * 8]);
    float qq = 0.f;
#pragma unroll
    for (int d0 = 0; d0 < 4; ++d0)
#pragma unroll
        for (int e = 0; e < 8; ++e) { const float v = __builtin_bit_cast(float, ((unsigned)(unsigned short)qr[d0][e]) << 16); qq += v * v; }
    qq += partner(qq);
    const int vh = DIFF ? 8 + 2 * h + br : h;
    const float k2 = __uint_as_float(T.kmax()[(b * 16 + vh) * 2]) + __uint_as_float(T.kmax()[(b * 16 + vh) * 2 + 1]);
    const float smax = 1.02f * sqrtf(qq * k2) + 0.05f;
    float mhat = 0.f, l_reg = 0.f; bool started = false;
    f32x16 o[NG];
#pragma unroll
    for (int g = 0; g < NG; ++g) o[g] = f32x16{};
    int sl_cur = 0, sl_n1 = STAGE, sl_n2 = 2 * STAGE;
    float need_alt = 0.f;
    const lds_cptr L3 = (lds_cptr)lds;
    for (int j = 0; j < nsteps; ++j) {
        const int t = t_hi - j;
        if (j + 1 < nsteps) { if constexpr (DIFF) { ATT_WAIT_BAR(4); } else { ATT_WAIT_BAR(2); } } else { ATT_WAIT_BAR(0); }
        if (j == 0) {
            const float bii = DIFF ? sl2 * (float)irow : ((LAS const float*)(lds + L_FBT))[irow];
            need_alt = 2.f * smax - bii;
            float nw = need_alt; nw = fmaxf(nw, partner(nw));
#pragma unroll
            for (int off = 1; off < 32; off <<= 1) nw = fmaxf(nw, __shfl_xor(nw, off));
            if (lane == 0) { needs[wid] = nw; needs[8 + wid] = nw; }
        } else {
            const LAS float* nd = needs + ((j & 1) ? 8 : 0);
            float nm = nd[0];
#pragma unroll
            for (int w = 1; w < 8; ++w) nm = fmaxf(nm, nd[w]);
            const float bmax = DIFF ? sl2 * (float)(64 * t + 63) : ((LAS const float*)(lds + L_FBT))[64 * t + 63];
            if (t < c_first && nm + bmax < -SKIP_T) break;
        }
        if (j + 2 < nsteps) ATT_ISSUE(t - 2, sl_n2);
        float need_w = need_alt;
        if (t <= c_w) {
            const bool diag = (t == c_w);
            f32x16 p0, p1;
            float sl2v = sl2; asm volatile("" : "+v"(sl2v));
            if (!DIFF) {
                const LAS float* fbt = (LAS const float*)(lds + L_FBT) + 64 * t + 4 * hi;
#pragma unroll
                for (int g4 = 0; g4 < 4; ++g4) { const f32x4 a = *(const LAS f32x4*)(fbt + 8 * g4), c = *(const LAS f32x4*)(fbt + 32 + 8 * g4);
#pragma unroll
                    for (int i = 0; i < 4; ++i) { p0[4 * g4 + i] = a[i] - mhat; p1[4 * g4 + i] = c[i] - mhat; } }
            } else if (!diag) {
                const float base = sl2v * (float)(64 * t + 4 * hi) - mhat;
#pragma unroll
                for (int r = 0; r < 16; ++r) { p0[r] = base + sl2v * (float)((r & 3) + 8 * (r >> 2)); p1[r] = p0[r] + 32.f * sl2v; }
            } else {
#pragma unroll
                for (int r = 0; r < 16; ++r) { const int jk = 64 * t + crow(r, hi);
                    const int d0_ = irow - jk, d1_ = irow - (jk + 32);
                    p0[r] = sl2v * (float)(irow - (d0_ < 0 ? -d0_ : d0_)) - mhat; p1[r] = sl2v * (float)(irow - (d1_ < 0 ? -d1_ : d1_)) - mhat; }
            }
            { const lds_cptr kb = L3 + sl_cur + (DIFF ? br * 8192 : 0) + hi * 1024 + r32 * 16;
#pragma unroll
              for (int d0 = 0; d0 < 4; ++d0) {
                  const bf16x8 b0 = *(const LAS bf16x8*)(kb + d0 * 2048), b1 = *(const LAS bf16x8*)(kb + d0 * 2048 + 512);
                  p0 = __builtin_amdgcn_mfma_f32_32x32x16_bf16(b0, qr[d0], p0, 0, 0, 0); p1 = __builtin_amdgcn_mfma_f32_32x32x16_bf16(b1, qr[d0], p1, 0, 0, 0);
                  if (d0 == 1) asm volatile("" ::: "memory"); } }
            if (!DIFF && diag) {
                const int qrel = 32 * (sub & 1) + r32;
#pragma unroll
                for (int r = 0; r < 16; ++r) { const int kv = crow(r, hi); if (kv > qrel) p0[r] = -__builtin_inff(); if (kv + 32 > qrel) p1[r] = -__builtin_inff(); }
            }
            float rm = fmaxf(p0[0], p1[0]);
#pragma unroll
            for (int r = 1; r < 16; ++r) rm = fmaxf(rm, fmaxf(p0[r], p1[r]));
            rm = fmaxf(rm, partner(rm));
            bool resc = false; float fsc = 1.f;
            if (!started) { mhat = rm;
#pragma unroll
                for (int r = 0; r < 16; ++r) { p0[r] -= rm; p1[r] -= rm; }
                started = true;
            } else if (__any(rm > 6.0f)) { const float dl = fmaxf(rm, 0.f); mhat += dl;
#pragma unroll
                for (int r = 0; r < 16; ++r) { p0[r] -= dl; p1[r] -= dl; }
                fsc = __builtin_amdgcn_exp2f(-dl); l_reg *= fsc; resc = true;
            }
            if (resc) {
                if (hi == 0) wsf[r32] = fsc;
                LDS_WAIT();
#pragma unroll
                for (int r = 0; r < 16; ++r) { const float f = wsf[crow(r, hi)];
#pragma unroll
                    for (int g = 0; g < NG; ++g) o[g][r] *= f; }
            }
            float sacc = 0.f;
#pragma unroll
            for (int r = 0; r < 16; ++r) { p0[r] = __builtin_amdgcn_exp2f(p0[r]); p1[r] = __builtin_amdgcn_exp2f(p1[r]); sacc += p0[r] + p1[r]; }
            l_reg += sacc;
            u32x4 pw0, pw1, pw2, pw3;
            pw0 = (u32x4){cvtpk_s(p0[0], p0[1]), cvtpk_s(p0[2], p0[3]), cvtpk_s(p0[4], p0[5]), cvtpk_s(p0[6], p0[7])};
            pw1 = (u32x4){cvtpk_s(p0[8], p0[9]), cvtpk_s(p0[10], p0[11]), cvtpk_s(p0[12], p0[13]), cvtpk_s(p0[14], p0[15])};
            pw2 = (u32x4){cvtpk_s(p1[0], p1[1]), cvtpk_s(p1[2], p1[3]), cvtpk_s(p1[4], p1[5]), cvtpk_s(p1[6], p1[7])};
            pw3 = (u32x4){cvtpk_s(p1[8], p1[9]), cvtpk_s(p1[10], p1[11]), cvtpk_s(p1[12], p1[13]), cvtpk_s(p1[14], p1[15])};
            { const lds_cptr vp = L3 + sl_cur + KBYTES + ((lane >> 4) & 1) * 32 + (lane & 3) * 8 + (4 * hi + ((lane & 15) >> 2)) * 64;
#pragma unroll
              for (int g = 0; g < NG; ++g) {
                  s16x4 lo[4], hh[4];
#pragma unroll
                  for (int ks = 0; ks < 4; ++ks) { lo[ks] = vtr(vp + g * 4096 + ks * 1024); hh[ks] = vtr(vp + g * 4096 + ks * 1024 + 512); }
#define ATT_PK(k) (bf16x8){lo[k][0], lo[k][1], lo[k][2], lo[k][3], hh[k][0], hh[k][1], hh[k][2], hh[k][3]}
                  o[g] = __builtin_amdgcn_mfma_f32_32x32x16_bf16(__builtin_bit_cast(bf16x8, pw0), ATT_PK(0), o[g], 0, 0, 0);
                  o[g] = __builtin_amdgcn_mfma_f32_32x32x16_bf16(__builtin_bit_cast(bf16x8, pw1), ATT_PK(1), o[g], 0, 0, 0);
                  o[g] = __builtin_amdgcn_mfma_f32_32x32x16_bf16(__builtin_bit_cast(bf16x8, pw2), ATT_PK(2), o[g], 0, 0, 0);
                  o[g] = __builtin_amdgcn_mfma_f32_32x32x16_bf16(__builtin_bit_cast(bf16x8, pw3), ATT_PK(3), o[g], 0, 0, 0);
#undef ATT_PK
                  asm volatile("" ::: "memory");
              } }
            need_w = fminf(need_alt, smax - mhat);
        }
        { float nw = need_w; nw = fmaxf(nw, partner(nw));
#pragma unroll
          for (int off = 1; off < 32; off <<= 1) nw = fmaxf(nw, __shfl_xor(nw, off));
          if (lane == 0) needs[((j + 1) & 1) ? 8 + wid : wid] = nw; }
        { const int tmp = sl_cur; sl_cur = sl_n1; sl_n1 = sl_n2; sl_n2 = tmp; }
    }
    ATT_WAIT_BAR(0);
#undef ATT_ISSUE
    int lane_e = lane; asm volatile("" : "+v"(lane_e)); const int r32e = lane_e & 31, hie = lane_e >> 5;
    const float lsum = l_reg + partner(l_reg);
    if (DIFF && partial) {
        float* po = (float*)(T.part() + (size_t)slot * PART_SLOT) + (size_t)wid * 4096;
#pragma unroll
        for (int g = 0; g < NG; ++g)
#pragma unroll
            for (int r = 0; r < 16; ++r) po[(g * 16 + r) * 64 + lane_e] = o[g][r];
        if (hie == 0) { f32x2* pml = (f32x2*)(T.part() + (size_t)slot * PART_SLOT + 8 * 64 * 64 * 4) + wid * 32 + r32e; *pml = (f32x2){mhat, lsum}; }
        return;
    }
    if (hie == 0) wsf[r32e] = lsum;
    LDS_WAIT();
    float inv[16];
#pragma unroll
    for (int r = 0; r < 16; ++r) inv[r] = __builtin_amdgcn_rcpf(wsf[crow(r, hie)]);
    if (!DIFF) {
        bf16_t* Ow = T.oa() + (rowbase + q0 + 32 * sub) * 512 + h * 64;
#pragma unroll
        for (int g = 0; g < NG; ++g)
#pragma unroll
            for (int r = 0; r < 16; ++r) Ow[(size_t)crow(r, hie) * 512 + 32 * g + r32e] = (bf16_t)f2bf(o[g][r] * inv[r]);
    } else {
        if constexpr (DIFF) diff_finish(o, inv, wid, lane_e, lds + RING_OFF, T, b, h, q0);
    }
}

__device__ __forceinline__ void decode_unit(int idx, unsigned& desc, unsigned& slot, int& cost) {
    if (idx < 512) { const int b = idx >> 8, h = (idx >> 5) & 7, qb = idx & 31; desc = 0u | (b << 1) | (h << 2) | (qb << 5) | (1u << 14); slot = 0; const int nt = 4 * qb + 4; cost = (nt < 11 ? nt : 11) * 2 / 3; return; }
    int r = idx - 512; const int b = r / 400; r -= b * 400;
    int h, qb, seg = 0, nseg = 1; slot = 0;
    if (r < 64) { h = 0; qb = r; }
    else if (r < 128) { h = 1; qb = r - 64; }
    else if (r < 240) { h = 2; const int r2 = r - 128; if (r2 < 16) qb = r2; else { qb = 16 + ((r2 - 16) >> 1); seg = (r2 - 16) & 1; nseg = 2; slot = (b * 48 + (qb - 16)) * 2; } }
    else { h = 3; const int r3 = r - 240;
        if (r3 < 16) qb = r3;
        else if (r3 < 48) { qb = 16 + ((r3 - 16) >> 1); seg = (r3 - 16) & 1; nseg = 2; slot = 192 + b * 144 + 2 * (qb - 16); }
        else if (r3 < 96) { qb = 32 + (r3 - 48) / 3; seg = (r3 - 48) % 3; nseg = 3; slot = 192 + b * 144 + 32 + 3 * (qb - 32); }
        else { qb = 48 + ((r3 - 96) >> 2); seg = (r3 - 96) & 3; nseg = 4; slot = 192 + b * 144 + 80 + 4 * (qb - 48); } }
    desc = 1u | (b << 1) | (h << 2) | (qb << 5) | (seg << 11) | (nseg << 14);
    const int ntl = 2 * qb + 2, t_hi = ntl - 1 - seg * SEG, t_lo = (seg == nseg - 1) ? 0 : t_hi - SEG + 1; int len = t_hi - t_lo + 1;
    const int win = (h == 0) ? 5 : (h == 1) ? 14 : (h == 2) ? (seg == 0 ? 32 : 18) : 32;
    cost = len < win ? len : win;
}
constexpr int NUNITS = 512 + 2 * 400;
}

struct PolBase {
    int K;
    __device__ __forceinline__ void a_off_plain(const int (&rA)[2], const int (&cA2)[2], unsigned (&v0)[2], unsigned (&v1)[2]) const {
#pragma unroll
        for (int i = 0; i < 2; ++i) { v0[i] = (unsigned)(rA[i] * K * 2 + cA2[i]); v1[i] = v0[i] + (unsigned)(128 * K * 2); }
    }
};
struct PolInProj : PolBase {
    static constexpr bool PERM = true;
    const bf16_t* A; const bf16_t* Bt; pg8::StaticOrder so; bf16_t* qkv; bf16_t* gates; const float* b_gate; unsigned* kmax;
    __device__ __forceinline__ bool next(int i, pg8::Unit& u) const { return so.next(i, u); }
    __device__ __forceinline__ const char* a_ptr(const pg8::Unit& u) const { return (const char*)(A + (size_t)u.pm * 256 * K); }
    __device__ __forceinline__ const char* b_ptr(const pg8::Unit& u) const { return (const char*)(Bt + (size_t)u.pn * 256 * K); }
    __device__ __forceinline__ void a_off(const pg8::Unit&, const int (&rA)[2], const int (&cA2)[2], unsigned (&v0)[2], unsigned (&v1)[2]) const { a_off_plain(rA, cA2, v0, v1); }
    __device__ __forceinline__ bool keep(const pg8::Unit&) const { return false; }
    __device__ __forceinline__ void epilogue(pg8::Acc& acc, const pg8::Unit& u, int wr, int wc, int fr, int fq) const {
        const int row0 = u.pm * 256 + wr * 64 + fr, colw = wc * 32 + 8 * fq;
        if (u.pn < 12) {
            const int t6 = u.pn >> 1;
            bf16_t* base = qkv + (size_t)t6 * (QKV_STRIDE / 2) + (u.pn & 1) * 256 + colw;
            const float sc = (t6 == 0 || t6 == 3) ? C2 : 1.f;
            float kq[2] = {0.f, 0.f};
#pragma unroll
            for (int ai = 0; ai < 2; ++ai)
#pragma unroll
                for (int m = 0; m < 4; ++m) { bf16_t* rowp = base + (size_t)(row0 + ai * 128 + m * 16) * 512;
#pragma unroll
                    for (int bj = 0; bj < 2; ++bj) { const f32x4 v0 = acc[ai][bj][m][0] * sc, v1 = acc[ai][bj][m][1] * sc;
                        u32x4 w; w.x = cvt_pk_bf16(v0[0], v0[1]); w.y = cvt_pk_bf16(v0[2], v0[3]); w.z = cvt_pk_bf16(v1[0], v1[1]); w.w = cvt_pk_bf16(v1[2], v1[3]);
                        *(u32x4*)(rowp + bj * 128) = w;
                        if (t6 == 1 || t6 == 4) { float s = (v0[0] * v0[0] + v0[1] * v0[1]) + (v0[2] * v0[2] + v0[3] * v0[3]) + (v1[0] * v1[0] + v1[1] * v1[1]) + (v1[2] * v1[2] + v1[3] * v1[3]);
                            s += __shfl_xor(s, 16); s += __shfl_xor(s, 32); kq[bj] = fmaxf(kq[bj], s); } } }
            if (t6 == 1 || t6 == 4) {
#pragma unroll
                for (int bj = 0; bj < 2; ++bj) { float s = kq[bj];
#pragma unroll
                    for (int off = 1; off < 16; off <<= 1) s = fmaxf(s, __shfl_xor(s, off));
                    const int vhead = (t6 == 1 ? 0 : 8) + (u.pn & 1) * 4 + 2 * bj + (wc >> 1), bb = u.pm >> 5;
                    if ((threadIdx.x & 63) == 0) atomicMax(kmax + (bb * 16 + vhead) * 2 + (wc & 1), __float_as_uint(s * 1.01f)); }
            }
        } else {
            const int g = (u.pn - 12) >> 2, gcol = ((u.pn - 12) & 3) * 256 + colw;
            bf16_t* base = gates + (size_t)g * ((size_t)M * 1024) + gcol; const float* bias = b_gate + g * 1024 + gcol;
            f32x4 bv[2][2];
#pragma unroll
            for (int bj = 0; bj < 2; ++bj)
#pragma unroll
                for (int n = 0; n < 2; ++n) bv[bj][n] = *(const f32x4*)(bias + bj * 128 + 4 * n);
#pragma unroll
            for (int ai = 0; ai < 2; ++ai)
#pragma unroll
                for (int m = 0; m < 4; ++m) { bf16_t* rowp = base + (size_t)(row0 + ai * 128 + m * 16) * 1024;
#pragma unroll
                    for (int bj = 0; bj < 2; ++bj) { const f32x4 v0 = acc[ai][bj][m][0] + bv[bj][0], v1 = acc[ai][bj][m][1] + bv[bj][1];
                        u32x4 w; w.x = cvt_pk_bf16(fsigmoid(v0[0]), fsigmoid(v0[1])); w.y = cvt_pk_bf16(fsigmoid(v0[2]), fsigmoid(v0[3]));
                        w.z = cvt_pk_bf16(fsigmoid(v1[0]), fsigmoid(v1[1])); w.w = cvt_pk_bf16(fsigmoid(v1[2]), fsigmoid(v1[3]));
                        *(u32x4*)(rowp + bj * 128) = w; } }
        }
    }
};
struct PolGate : PolBase {
    static constexpr bool PERM = true;
    const bf16_t *OA, *OB, *Wpa, *Wpb; const bf16_t* gates; bf16_t* Y; pg8::StaticOrder so;
    __device__ __forceinline__ bool next(int i, pg8::Unit& u) const { if (!so.next(i >> 1, u)) return false; u.aux = i & 1; return true; }
    __device__ __forceinline__ const char* a_ptr(const pg8::Unit& u) const { return (const char*)((u.aux ? OB : OA) + (size_t)u.pm * 256 * K); }
    __device__ __forceinline__ const char* b_ptr(const pg8::Unit& u) const { return (const char*)((u.aux ? Wpb : Wpa) + (size_t)u.pn * 256 * K); }
    __device__ __forceinline__ void a_off(const pg8::Unit&, const int (&rA)[2], const int (&cA2)[2], unsigned (&v0)[2], unsigned (&v1)[2]) const { a_off_plain(rA, cA2, v0, v1); }
    __device__ __forceinline__ bool keep(const pg8::Unit& u) const { return u.aux == 0; }
    __device__ __forceinline__ void epilogue(pg8::Acc& acc, const pg8::Unit& u, int wr, int wc, int fr, int fq) const {
        const int row0 = u.pm * 256 + wr * 64 + fr, col0 = u.pn * 256 + wc * 32 + 8 * fq;
        const bf16_t* ga = gates + col0; const bf16_t* gb = gates + (size_t)M * 1024 + col0;
#pragma unroll
        for (int ai = 0; ai < 2; ++ai)
#pragma unroll
            for (int m = 0; m < 4; ++m) { const size_t ro = (size_t)(row0 + ai * 128 + m * 16) * 1024;
#pragma unroll
                for (int bj = 0; bj < 2; ++bj) {
                    const u32x4 b = *(const u32x4*)(gb + ro + bj * 128);
                    if (u.aux == 0) {
                        const u32x4 a = *(const u32x4*)(ga + ro + bj * 128);
                        f32x4 r0, r1;
                        r0[0] = bf_lo(a.x) * __builtin_amdgcn_rcpf(fmaxf(bf_lo(b.x), 1e-30f)); r0[1] = bf_hi(a.x) * __builtin_amdgcn_rcpf(fmaxf(bf_hi(b.x), 1e-30f));
                        r0[2] = bf_lo(a.y) * __builtin_amdgcn_rcpf(fmaxf(bf_lo(b.y), 1e-30f)); r0[3] = bf_hi(a.y) * __builtin_amdgcn_rcpf(fmaxf(bf_hi(b.y), 1e-30f));
                        r1[0] = bf_lo(a.z) * __builtin_amdgcn_rcpf(fmaxf(bf_lo(b.z), 1e-30f)); r1[1] = bf_hi(a.z) * __builtin_amdgcn_rcpf(fmaxf(bf_hi(b.z), 1e-30f));
                        r1[2] = bf_lo(a.w) * __builtin_amdgcn_rcpf(fmaxf(bf_lo(b.w), 1e-30f)); r1[3] = bf_hi(a.w) * __builtin_amdgcn_rcpf(fmaxf(bf_hi(b.w), 1e-30f));
                        acc[ai][bj][m][0] *= r0; acc[ai][bj][m][1] *= r1;
                    } else {
                        const f32x4 v0 = acc[ai][bj][m][0], v1 = acc[ai][bj][m][1];
                        u32x4 w; w.x = cvt_pk_bf16(v0[0] * bf_lo(b.x), v0[1] * bf_hi(b.x)); w.y = cvt_pk_bf16(v0[2] * bf_lo(b.y), v0[3] * bf_hi(b.y));
                        w.z = cvt_pk_bf16(v1[0] * bf_lo(b.z), v1[1] * bf_hi(b.z)); w.w = cvt_pk_bf16(v1[2] * bf_lo(b.w), v1[3] * bf_hi(b.w));
                        *(u32x4*)(Y + ro + col0 + bj * 128) = w;
                    } } }
    }
};
struct PolWo : PolBase {
    static constexpr bool PERM = false;
    const bf16_t* A; const bf16_t* Bt; const float* x; float* x1; pg8::StaticOrder so;
    __device__ __forceinline__ bool next(int i, pg8::Unit& u) const { return so.next(i, u); }
    __device__ __forceinline__ const char* a_ptr(const pg8::Unit& u) const { return (const char*)(A + (size_t)u.pm * 256 * K); }
    __device__ __forceinline__ const char* b_ptr(const pg8::Unit& u) const { return (const char*)(Bt + (size_t)u.pn * 256 * K); }
    __device__ __forceinline__ void a_off(const pg8::Unit&, const int (&rA)[2], const int (&cA2)[2], unsigned (&v0)[2], unsigned (&v1)[2]) const { a_off_plain(rA, cA2, v0, v1); }
    __device__ __forceinline__ bool keep(const pg8::Unit&) const { return false; }
    __device__ __forceinline__ void epilogue(pg8::Acc& acc, const pg8::Unit& u, int wr, int wc, int fr, int fq) const {
        const int row0 = u.pm * 256 + wr * 64 + fr, col0 = u.pn * 256 + wc * 32 + 4 * fq;
#pragma unroll
        for (int ai = 0; ai < 2; ++ai)
#pragma unroll
            for (int m = 0; m < 4; ++m) { const size_t off = (size_t)(row0 + ai * 128 + m * 16) * 1024 + col0;
#pragma unroll
                for (int bj = 0; bj < 2; ++bj)
#pragma unroll
                    for (int n = 0; n < 2; ++n) { const f32x4 bs = *(const f32x4*)(x + off + bj * 128 + n * 16); *(f32x4*)(x1 + off + bj * 128 + n * 16) = bs + acc[ai][bj][m][n]; } }
    }
};
struct PolUp : PolBase {
    static constexpr bool PERM = true;
    const bf16_t* H2; const bf16_t* Wup; bf16_t* H; const int* row_tok; const int* tile_e; int ntiles, G, c;
    __device__ __forceinline__ bool next(int i, pg8::Unit& u) const { const int L = i * G + c; const int tile = L >> 2; if (tile >= ntiles) return false; u.pm = tile; u.pn = L & 3; u.aux = tile_e[tile]; return true; }
    __device__ __forceinline__ const char* a_ptr(const pg8::Unit&) const { return (const char*)H2; }
    __device__ __forceinline__ const char* b_ptr(const pg8::Unit& u) const { return (const char*)(Wup + ((size_t)u.aux * 1024 + (size_t)u.pn * 256) * 1024); }
    __device__ __forceinline__ void a_off(const pg8::Unit& u, const int (&rA)[2], const int (&cA2)[2], unsigned (&v0)[2], unsigned (&v1)[2]) const {
#pragma unroll
        for (int i = 0; i < 2; ++i) { const int t0 = row_tok[u.pm * 256 + rA[i]], t1 = row_tok[u.pm * 256 + 128 + rA[i]];
            v0[i] = (unsigned)(t0 * 2048 + cA2[i]); v1[i] = (unsigned)(t1 * 2048 + cA2[i]); }
    }
    __device__ __forceinline__ bool keep(const pg8::Unit&) const { return false; }
    __device__ __forceinline__ void epilogue(pg8::Acc& acc, const pg8::Unit& u, int wr, int wc, int fr, int fq) const {
        const int row0 = u.pm * 256 + wr * 64 + fr, col0 = u.pn * 128 + wc * 32 + 8 * fq;
#pragma unroll
        for (int ai = 0; ai < 2; ++ai)
#pragma unroll
            for (int m = 0; m < 4; ++m) { bf16_t* rowp = H + (size_t)(row0 + ai * 128 + m * 16) * 512 + col0;
                const f32x4 a0 = acc[ai][0][m][0], a1 = acc[ai][0][m][1], g0 = acc[ai][1][m][0], g1 = acc[ai][1][m][1];
                u32x4 w;
                w.x = cvt_pk_bf16(a0[0] * fsigmoid(a0[0]) * g0[0], a0[1] * fsigmoid(a0[1]) * g0[1]); w.y = cvt_pk_bf16(a0[2] * fsigmoid(a0[2]) * g0[2], a0[3] * fsigmoid(a0[3]) * g0[3]);
                w.z = cvt_pk_bf16(a1[0] * fsigmoid(a1[0]) * g1[0], a1[1] * fsigmoid(a1[1]) * g1[1]); w.w = cvt_pk_bf16(a1[2] * fsigmoid(a1[2]) * g1[2], a1[3] * fsigmoid(a1[3]) * g1[3]);
                *(u32x4*)rowp = w; }
    }
};
struct PolDown : PolBase {
    static constexpr bool PERM = true;
    const bf16_t* Hb; const bf16_t* Wdn; bf16_t* Yexp; const int* row_dst; const float* row_w; const int* tile_e; int ntiles, G, c;
    __device__ __forceinline__ bool next(int i, pg8::Unit& u) const { const int L = i * G + c; const int tile = L >> 2; if (tile >= ntiles) return false; u.pm = tile; u.pn = L & 3; u.aux = tile_e[tile]; return true; }
    __device__ __forceinline__ const char* a_ptr(const pg8::Unit& u) const { return (const char*)(Hb + (size_t)u.pm * 256 * K); }
    __device__ __forceinline__ const char* b_ptr(const pg8::Unit& u) const { return (const char*)(Wdn + ((size_t)u.aux * 1024 + (size_t)u.pn * 256) * 512); }
    __device__ __forceinline__ void a_off(const pg8::Unit&, const int (&rA)[2], const int (&cA2)[2], unsigned (&v0)[2], unsigned (&v1)[2]) const { a_off_plain(rA, cA2, v0, v1); }
    __device__ __forceinline__ bool keep(const pg8::Unit&) const { return false; }
    __device__ __forceinline__ void epilogue(pg8::Acc& acc, const pg8::Unit& u, int wr, int wc, int fr, int fq) const {
        const int row0 = u.pm * 256 + wr * 64 + fr, col0 = u.pn * 256 + wc * 32 + 8 * fq;
#pragma unroll
        for (int ai = 0; ai < 2; ++ai)
#pragma unroll
            for (int m = 0; m < 4; ++m) { const int r = row0 + ai * 128 + m * 16; const int dst = row_dst[r]; const float w_ = row_w[r];
                if (dst >= 0) { bf16_t* rowp = Yexp + (size_t)dst * 1024 + col0;
#pragma unroll
                    for (int bj = 0; bj < 2; ++bj) { const f32x4 v0 = acc[ai][bj][m][0] * w_, v1 = acc[ai][bj][m][1] * w_;
                        u32x4 w; w.x = cvt_pk_bf16(v0[0], v0[1]); w.y = cvt_pk_bf16(v0[2], v0[3]); w.z = cvt_pk_bf16(v1[0], v1[1]); w.w = cvt_pk_bf16(v1[2], v1[3]);
                        *(u32x4*)(rowp + bj * 128) = w; } } }
    }
};

constexpr int NPH = 11;
__global__ void __launch_bounds__(NWAVES * 64, 2) mk_fwd(Args args_unused) {
    extern __shared__ __attribute__((aligned(16))) unsigned char lds_raw[];
    typedef const Args __attribute__((address_space(4))) CArgs;
#define ARG(f) ([&]() { CArgs* p_ = (CArgs*)__builtin_amdgcn_kernarg_segment_ptr(); asm volatile("" : "+s"(p_)); return p_->f; }())
    Frame F;
    F.lds = (LAS unsigned char*)lds_raw;
    F.tid = threadIdx.x; F.lane = F.tid & 63; F.wave = __builtin_amdgcn_readfirstlane(F.tid >> 6);
    F.G = gridDim.x; { const int bx = blockIdx.x; F.vcu = (F.G % 8 == 0) ? (bx % 8) * (F.G / 8) + bx / 8 : bx; }
    unsigned char* ws = ARG(ws); F.ws = ws; F.ctl = (gu32*)(ws + WS_CTL);
    volatile LAS unsigned* MISC = (volatile LAS unsigned*)(F.lds + MISC_OFF);
    for (int u = F.tid; u < (LDS_BYTES - MISC_OFF) / 4; u += NWAVES * 64) ((LAS unsigned*)(F.lds + MISC_OFF))[u] = 0u;
    __syncthreads();
    XcdBarrier bar; bar.bar = (unsigned*)(F.ctl + CW_BAR); bar.x = 0; bar.st = nullptr;
    if (MK_N_LAUNCHES == 1) bar = xcd_barrier_post((unsigned*)(F.ctl + CW_BAR), MISC + 8);
    const int lo = ARG(ph_lo), hi = ARG(ph_hi);
#if defined(DBG_STAGE)
    if (lo > DBG_STAGE + 1) return;
#endif
#ifndef PH_MASK
#define PH_MASK 0xFFFF
#endif
#define IN(k) (((PH_MASK >> (k)) & 1) && lo <= (k) && (k) < hi)
#define SEAM(k) do { if (IN(k) && IN((k) + 1)) xcd_barrier(bar); } while (0)
    const int gw = F.vcu * NWAVES + F.wave, NGW = F.G * NWAVES;
    bf16_t* Win_t = (bf16_t*)(ws + WS_WIN); bf16_t* Wpa_t = (bf16_t*)(ws + WS_WPA); bf16_t* Wpb_t = (bf16_t*)(ws + WS_WPB); bf16_t* Wo_t = (bf16_t*)(ws + WS_WO);
    bf16_t* XN = (bf16_t*)(ws + WS_C); bf16_t* OA = (bf16_t*)(ws + WS_OA); bf16_t* OB = (bf16_t*)(ws + WS_OB); bf16_t* H2 = (bf16_t*)(ws + WS_C);
    bf16_t* QKV = (bf16_t*)(ws + WS_D); bf16_t* Wup = (bf16_t*)(ws + WS_UP); bf16_t* Wdn = (bf16_t*)(ws + WS_DN); bf16_t* YEXP = (bf16_t*)(ws + WS_YEXP);
    bf16_t* Y = (bf16_t*)(ws + WS_Y); float* X1 = (float*)(ws + WS_X1); bf16_t* GATES = (bf16_t*)ARG(out); bf16_t* HB = (bf16_t*)ARG(out);
    unsigned char* misc = ws + WS_MISC;
    float* LF = (float*)(misc + MS_LF); float* FB = (float*)(misc + MS_FB); u32x2* UNITS = (u32x2*)(misc + MS_UNITS);
    int* ASG_E = (int*)(misc + MS_ASG); float* ASG_W = (float*)(misc + MS_ASG + (size_t)M * 8); int* ASG_R = (int*)(misc + MS_ASG + (size_t)M * 16);
    int* HIST = (int*)(misc + MS_HIST); int* ROW_TOK = (int*)(misc + MS_ROWTOK); int* ROW_DST = (int*)(misc + MS_ROWDST); float* ROW_W = (float*)(misc + MS_ROWW); int* TILE_E = (int*)(misc + MS_TILEE);

    if (IN(0)) {
        LAS float* scr = (LAS float*)(F.lds + RING_OFF + F.wave * 8704);
        if ((int)blockIdx.x == F.G - 1) {
            LAS int* cnt = (LAS int*)(F.lds + 98304);
            if (F.tid < 64) cnt[F.tid] = 0;
            __syncthreads();
            for (int i = F.tid; i < att::NUNITS; i += 512) { unsigned d, s; int c; att::decode_unit(i, d, s, c); __hip_atomic_fetch_add(&cnt[40 - c], 1, __ATOMIC_RELAXED, __HIP_MEMORY_SCOPE_WORKGROUP); }
            __syncthreads();
            if (F.tid == 0) { int run = 0; for (int k = 0; k < 64; ++k) { const int c = cnt[k]; cnt[k] = run; run += c; } }
            __syncthreads();
            for (int i = F.tid; i < att::NUNITS; i += 512) { unsigned d, s; int c; att::decode_unit(i, d, s, c); const int pos = __hip_atomic_fetch_add(&cnt[40 - c], 1, __ATOMIC_RELAXED, __HIP_MEMORY_SCOPE_WORKGROUP); UNITS[pos] = (u32x2){d, s}; }
            __syncthreads();
        }
        {
            constexpr int I_IN = 16 * 160, I_PA = 8 * 32, I_WO = 16 * 32, NIT = I_IN + 2 * I_PA + I_WO;
            for (int it = gw; it < NIT; it += NGW) {
                int r = it;
                if (r < I_IN) { const int kb = r / 160, nb = r % 160, n0 = 32 * nb, sc = n0 + (n0 >= 1536 ? 8 : 0); transpose_item(ARG(w_in) + (size_t)(64 * kb) * 5128 + sc, 5128, Win_t + (size_t)n0 * 1024 + 64 * kb, 1024, scr, F.lane); continue; } r -= I_IN;
                if (r < I_PA) { const int kb = r / 32, nb = r % 32; transpose_item(ARG(w_pa) + (size_t)(64 * kb) * 1024 + 32 * nb, 1024, Wpa_t + (size_t)(32 * nb) * 512 + 64 * kb, 512, scr, F.lane); continue; } r -= I_PA;
                if (r < I_PA) { const int kb = r / 32, nb = r % 32; transpose_item(ARG(w_pb) + (size_t)(64 * kb) * 1024 + 32 * nb, 1024, Wpb_t + (size_t)(32 * nb) * 512 + 64 * kb, 512, scr, F.lane); continue; } r -= I_PA;
                { const int kb = r / 32, nb = r % 32; transpose_item(ARG(w_o) + (size_t)(64 * kb) * 1024 + 32 * nb, 1024, Wo_t + (size_t)(32 * nb) * 1024 + 64 * kb, 1024, scr, F.lane); }
            }
        }
        {
            LAS float* wf = (LAS float*)(F.lds + 73728);
            __syncthreads();
            for (int i = F.tid; i < 8192; i += 512) { const int k = i >> 3, c = i & 7; wf[c * 1024 + k] = ARG(w_in)[(size_t)k * 5128 + 1536 + c]; }
            __syncthreads();
            for (int m = gw; m < M; m += NGW) {
                const GAS f32x4* xr = (const GAS f32x4*)(ARG(x) + (size_t)m * DM) + F.lane;
                f32x4 v[4]; float s = 0.f;
#pragma unroll
                for (int j = 0; j < 4; ++j) { v[j] = xr[64 * j]; s += (v[j].x * v[j].x + v[j].y * v[j].y) + (v[j].z * v[j].z + v[j].w * v[j].w); }
                const float rstd = 1.0f / sqrtf(wave_sum(s) * (1.f / DM) + EPS);
                float fa[8];
#pragma unroll
                for (int c = 0; c < 8; ++c) fa[c] = 0.f;
                GAS unsigned long long* o8 = (GAS unsigned long long*)(XN + (size_t)m * DM) + F.lane;
#pragma unroll
                for (int j = 0; j < 4; ++j) { const f32x4 g = *((const GAS f32x4*)ARG(g_mix) + 64 * j + F.lane); const f32x4 hv = v[j] * rstd * g;
                    o8[64 * j] = (unsigned long long)pk2(hv.x, hv.y) | ((unsigned long long)pk2(hv.z, hv.w) << 32);
#pragma unroll
                    for (int c = 0; c < 8; ++c) { const f32x4 w = *(const LAS f32x4*)(wf + c * 1024 + 4 * (64 * j + F.lane)); fa[c] += (hv.x * w.x + hv.y * w.y) + (hv.z * w.z + hv.w * w.w); } }
#pragma unroll
                for (int c = 0; c < 8; ++c) fa[c] = wave_sum(fa[c]);
                if (F.lane < 8) { float z = 0.f;
#pragma unroll
                    for (int c = 0; c < 8; ++c) z = (F.lane == c) ? fa[c] : z;
                    z += ARG(b_fgate)[F.lane];
                    const float ls = (z >= 0.f) ? -log1pf(expf(-z)) : (z - log1pf(expf(z)));
                    const int bb = m >> 13, sidx = m & (SEQ - 1);
                    LF[(size_t)(bb * 8 + F.lane) * SEQ + sidx] = ls; }
            }
        }
    }
    SEAM(0);

    if (IN(1)) {
        if ((int)blockIdx.x < 16) {
            const float* lf = LF + (size_t)blockIdx.x * SEQ; float* fb = FB + (size_t)blockIdx.x * SEQ;
            LAS float* wt = (LAS float*)(F.lds + RING_OFF);
            float v[16]; float run = 0.f;
#pragma unroll
            for (int i = 0; i < 4; ++i) { const f32x4 a = *(const f32x4*)(lf + F.tid * 16 + 4 * i); v[4 * i] = a.x; v[4 * i + 1] = a.y; v[4 * i + 2] = a.z; v[4 * i + 3] = a.w; }
#pragma unroll
            for (int i = 0; i < 16; ++i) { run += v[i]; v[i] = run; }
            float incl = run;
#pragma unroll
            for (int off = 1; off < 64; off <<= 1) { const float n = __shfl_up(incl, off); if (F.lane >= off) incl += n; }
            if (F.lane == 63) wt[F.wave] = incl;
            __syncthreads();
            float base = incl - run;
            for (int w = 0; w < F.wave; ++w) base += wt[w];
#pragma unroll
            for (int i = 0; i < 4; ++i) { f32x4 a; a.x = -(v[4 * i] + base) * LOG2E; a.y = -(v[4 * i + 1] + base) * LOG2E; a.z = -(v[4 * i + 2] + base) * LOG2E; a.w = -(v[4 * i + 3] + base) * LOG2E; *(f32x4*)(fb + F.tid * 16 + 4 * i) = a; }
            __syncthreads();
        }
        PolInProj P; P.K = DM; P.A = XN; P.Bt = Win_t; P.so.init(M, NPROJ, F.G, (int)blockIdx.x); P.qkv = QKV; P.gates = GATES; P.b_gate = ARG(b_gate); P.kmax = (unsigned*)(F.ctl + CW_KMAX);
        pg8::gemm_run(F.lds + RING_OFF, P);
    }
    SEAM(1);

#if defined(DBG_STAGE)
#define DBG_DUMP(stage, EXPR) if (DBG_STAGE == (stage) && IN((stage) + 1)) { __syncthreads(); \
        for (int m = gw; m < M; m += NGW) { for (int q = 0; q < 16; ++q) { const int c = q * 64 + F.lane; ARG(out)[(size_t)m * DM + c] = (EXPR); } } return; }
#else
#define DBG_DUMP(stage, EXPR)
#endif
#define BF(p) bf_lo((unsigned)(p))
    DBG_DUMP(1, BF(QKV[(size_t)m * 512 + (c & 511)]) * (c < 512 ? 1.f : 0.f) + BF(QKV[(QKV_STRIDE / 2) + (size_t)m * 512 + (c & 511)]) * (c < 512 ? 0.f : 1.f)
        + 3.f * BF(QKV[2 * (QKV_STRIDE / 2) + (size_t)m * 512 + (c & 511)]) * (c < 512 ? 1.f : 0.f) + 3.f * BF(QKV[3 * (QKV_STRIDE / 2) + (size_t)m * 512 + (c & 511)]) * (c < 512 ? 0.f : 1.f)
        + 5.f * BF(QKV[4 * (QKV_STRIDE / 2) + (size_t)m * 512 + (c & 511)]) * (c < 512 ? 1.f : 0.f) + 5.f * BF(QKV[5 * (QKV_STRIDE / 2) + (size_t)m * 512 + (c & 511)]) * (c < 512 ? 0.f : 1.f) + 0.001f * FB[(size_t)((m >> 13) * 8 + (c & 7)) * SEQ + (m & 8191)])
#if defined(DBG_CHECK) && (DBG_CHECK == 3 || DBG_CHECK == 4)
#define DBG_CHK_PH 2
    if (IN(DBG_CHK_PH)) {
        unsigned* dmax = (unsigned*)(F.ctl + 300);
        float md = 0.f;
        const int rows14[14] = {0, 31, 32, 63, 64, 100, 255, 256, 511, 1000, 2047, 4096, 5000, 8191};
        if (DBG_CHECK == 1) {
            for (int task = gw; task < 16 * 14; task += NGW) {
                const int bh = task / 14, b = bh >> 3, h = bh & 7; int i = 0;
                for (int q = 0; q < 14; ++q) if (q == task % 14) i = rows14[q];
                const bf16_t* Q = QKV + ((size_t)b * SEQ + i) * 512 + h * 64; const bf16_t* Kp = QKV + QKV_STRIDE / 2 + (size_t)b * SEQ * 512 + h * 64; const bf16_t* Vp = QKV + 2 * (QKV_STRIDE / 2) + (size_t)b * SEQ * 512 + h * 64;
                const float* fb = FB + (size_t)bh * SEQ;
                const float qd = BF(Q[F.lane]); float m = -1e30f, l = 0.f, acc = 0.f;
                for (int j = i; j >= 0; --j) { const float sc = wave_sum(qd * BF(Kp[(size_t)j * 512 + F.lane])) + fb[j];
                    const float mn = fmaxf(m, sc), f = __builtin_amdgcn_exp2f(m - mn), p = __builtin_amdgcn_exp2f(sc - mn); l = l * f + p; acc = acc * f + p * BF(Vp[(size_t)j * 512 + F.lane]); m = mn; }
                const float ref = acc / l, got = BF(OA[((size_t)b * SEQ + i) * 512 + h * 64 + F.lane]);
                md = fmaxf(md, fabsf(ref - got));
            }
        } else if (DBG_CHECK == 2) {
            const float lam = expf(wave_sum(ARG(lq1)[F.lane] * ARG(lk1)[F.lane])) - expf(wave_sum(ARG(lq2)[F.lane] * ARG(lk2)[F.lane])) + LAM_INIT;
            for (int task = gw; task < 8 * 14; task += NGW) {
                const int bh = task / 14, b = bh >> 2, h = bh & 3; int i = 0;
                for (int q = 0; q < 14; ++q) if (q == task % 14) i = rows14[q];
                const float sl2 = LOG2E * __builtin_amdgcn_exp2f(-2.0f * (float)(h + 1));
                const bf16_t* Q = QKV + 3 * (QKV_STRIDE / 2) + ((size_t)b * SEQ + i) * 512 + h * 128; const bf16_t* Kp = QKV + 4 * (QKV_STRIDE / 2) + (size_t)b * SEQ * 512 + h * 128; const bf16_t* Vp = QKV + 5 * (QKV_STRIDE / 2) + (size_t)b * SEQ * 512 + h * 128;
                const float q1 = BF(Q[F.lane]), q2 = BF(Q[64 + F.lane]); float m1 = -1e30f, l1 = 0.f, a1 = 0.f, c1 = 0.f, m2 = -1e30f, l2 = 0.f, a2 = 0.f, c2 = 0.f;
                const int jmax = (i | 63);
                const int jlo_ = ((jmax >> 6) - (DBG_NTILES - 1)) > 0 ? ((jmax >> 6) - (DBG_NTILES - 1)) * 64 : 0;
                for (int j = jmax; j >= jlo_; --j) { const float bias = -sl2 * fabsf((float)(i - j));
                    const float s1 = wave_sum(q1 * BF(Kp[(size_t)j * 512 + F.lane])) + bias, s2 = wave_sum(q2 * BF(Kp[(size_t)j * 512 + 64 + F.lane])) + bias;
                    const float va = BF(Vp[(size_t)j * 512 + F.lane]), vb = BF(Vp[(size_t)j * 512 + 64 + F.lane]);
                    { const float mn = fmaxf(m1, s1), f = __builtin_amdgcn_exp2f(m1 - mn), p = __builtin_amdgcn_exp2f(s1 - mn); l1 = l1 * f + p; a1 = a1 * f + p * va; c1 = c1 * f + p * vb; m1 = mn; }
                    { const float mn = fmaxf(m2, s2), f = __builtin_amdgcn_exp2f(m2 - mn), p = __builtin_amdgcn_exp2f(s2 - mn); l2 = l2 * f + p; a2 = a2 * f + p * va; c2 = c2 * f + p * vb; m2 = mn; } }
                const float oa_ = a1 / l1 - lam * a2 / l2, ob_ = c1 / l1 - lam * c2 / l2;
                const float rstd = 0.8f / sqrtf(wave_sum(oa_ * oa_ + ob_ * ob_) * (1.f / 128.f) + EPS);
                const float r0 = oa_ * rstd * ARG(g_subln)[F.lane], r1 = ob_ * rstd * ARG(g_subln)[64 + F.lane];
                const float g0 = BF(OB[((size_t)b * SEQ + i) * 512 + h * 128 + F.lane]), g1 = BF(OB[((size_t)b * SEQ + i) * 512 + h * 128 + 64 + F.lane]);
                if (((DBG_SELH >> h) & 1) && ((DBG_SELR >> (task % 14)) & 1)) md = fmaxf(md, fmaxf(fabsf(r0 - g0), fabsf(r1 - g1)));
            }
        } else if (DBG_CHECK == 5) {
            const float* xp = ARG(x); const float* gm = ARG(g_mix);
            for (int task = gw; task < 8 * 14; task += NGW) {
                const int bh = task / 14, b = bh >> 2, h = bh & 3; int i = 0;
                for (int q = 0; q < 14; ++q) if (q == task % 14) i = rows14[q];
                if (!(((DBG_SELH >> h) & 1) && ((DBG_SELR >> (task % 14)) & 1))) continue;
                const size_t e = ((size_t)b * SEQ + i) * 512 + h * 128 + F.lane; const int m = 8192 + (int)(e >> 10), c = (int)(e & 1023);
                float ss = 0.f; for (int k = F.lane; k < 1024; k += 64) { const float v = xp[(size_t)m * 1024 + k]; ss += v * v; }
                const float rstd = 1.0f / sqrtf(wave_sum(ss) * (1.f / DM) + EPS);
                const float xn = BF((bf16_t)f2bf(xp[(size_t)m * 1024 + c] * rstd * gm[c]));
                md = fmaxf(md, fabsf(xn - BF(OB[e])));
            }
        } else if (DBG_CHECK == 3) {
            for (int task = gw; task < 4096; task += NGW) {
                const int mrow = (task * 2654435 + 977) & (M - 1);
                for (int q = 0; q < 4; ++q) { const int n = (task * 131 + q * 1283 + F.lane * 79 + 17) % 5120;
                    float d = 0.f; for (int k = 0; k < 1024; ++k) d += BF(XN[(size_t)mrow * 1024 + k]) * BF(Win_t[(size_t)n * 1024 + k]);
                    float got, ref;
                    if (n < 3072) { const int t6 = n / 512; got = BF(QKV[(size_t)t6 * (QKV_STRIDE / 2) + (size_t)mrow * 512 + (n % 512)]); ref = d * ((t6 == 0 || t6 == 3) ? C2 : 1.f); }
                    else { const int g = (n - 3072) / 1024, gc = (n - 3072) % 1024; got = BF(GATES[(size_t)g * M * 1024 + (size_t)mrow * 1024 + gc]); ref = 1.f / (1.f + expf(-(d + ARG(b_gate)[g * 1024 + gc]))); }
                    const int cls = (n < 3072) ? (n / 512) : 6 + (n - 3072) / 1024;
                    if ((DBG_SELH >> cls) & 1) { if (fabsf(got - ref) > 0.05f) md += 1.0f; } }
            }
        } else if (DBG_CHECK == 4) {
            for (int task = gw; task < 8192; task += NGW) {
                const int n = (task * 37 + F.lane * 83) % 5120, k = (task * 91 + F.lane * 7) & 1023; const int scol = n + (n >= 1536 ? 8 : 0);
                md = fmaxf(md, fabsf(BF(Win_t[(size_t)n * 1024 + k]) - BF((bf16_t)f2bf(ARG(w_in)[(size_t)k * 5128 + scol]))));
                const int n2 = (task * 53 + F.lane * 29) & 1023, k2 = (task * 17 + F.lane * 3) & 511;
                md = fmaxf(md, fabsf(BF(Wpa_t[(size_t)n2 * 512 + k2]) - BF((bf16_t)f2bf(ARG(w_pa)[(size_t)k2 * 1024 + n2]))));
                md = fmaxf(md, fabsf(BF(Wpb_t[(size_t)n2 * 512 + k2]) - BF((bf16_t)f2bf(ARG(w_pb)[(size_t)k2 * 1024 + n2]))));
                md = fmaxf(md, fabsf(BF(Wo_t[(size_t)n2 * 1024 + k]) - BF((bf16_t)f2bf(ARG(w_o)[(size_t)k * 1024 + n2]))));
            }
        }
#if DBG_CHECK == 3
        md = wave_sum(md);
        if (F.lane == 0) atomicAdd((unsigned*)(F.ctl + 301), (unsigned)md);
        if (F.lane == 0) atomicMax(dmax, 0u);
#else
        md = wave_max(md);
        if (F.lane == 0) atomicMax(dmax, __float_as_uint(md));
#endif
        return;
    }
    if (IN(DBG_CHK_PH + 1)) { float d = __uint_as_float(__hip_atomic_load((unsigned*)(F.ctl + 300), RLX_AGENT)); if (DBG_CHECK == 3) d = 1e-3f * (float)__hip_atomic_load((unsigned*)(F.ctl + 301), RLX_AGENT); float* outp = ARG(out);
        for (int m = gw; m < M; m += NGW) for (int q = 0; q < 16; ++q) outp[(size_t)m * DM + q * 64 + F.lane] = (m == 0 && q == 0 && F.lane == 0) ? 1e4f * d : 0.f;
        return; }
    if (lo > DBG_CHK_PH + 1) return;
#endif
    if (IN(2)) {
        att::Tensors T; T.ws = ws; T.g_subln = ARG(g_subln);
        { const float a1 = wave_sum(ARG(lq1)[F.lane] * ARG(lk1)[F.lane]), a2 = wave_sum(ARG(lq2)[F.lane] * ARG(lk2)[F.lane]); T.lam = expf(a1) - expf(a2) + LAM_INIT; }
        LAS unsigned* qw = (LAS unsigned*)(F.lds + L_AUX + 128);
        for (;;) {
            if (F.tid == 0) qw[0] = __hip_atomic_fetch_add((unsigned*)(F.ctl + CW_QHEAD), 1u, RLX_AGENT);
            __syncthreads();
            const unsigned id = qw[0];
            __syncthreads();
            if (id >= (unsigned)att::NUNITS) break;
            const u32x2 ud = UNITS[id];
            const unsigned d = (unsigned)__builtin_amdgcn_readfirstlane(ud.x); const int slot0 = __builtin_amdgcn_readfirstlane(ud.y);
            const int b = (d >> 1) & 1, h = (d >> 2) & 7, qb = (d >> 5) & 63, seg = (d >> 11) & 7, nseg = (d >> 14) & 7;
#ifndef NO_FOX
            if ((d & 1u) == 0u) att::attn_unit<false>(T, b, h, qb, 0, 4 * qb + 3, false, 0, (LAS char*)F.lds);
            else
#endif
#ifndef NO_DIFF
            {
#if defined(DBG_NOSPLIT)
                if (seg == 0) att::attn_unit<true>(T, b, h, qb, (2 * qb + 1 - (DBG_NTILES - 1)) > 0 ? (2 * qb + 1 - (DBG_NTILES - 1)) : 0, 2 * qb + 1, false, 0, (LAS char*)F.lds);
#else
                const int t_hi = 2 * qb + 1 - seg * SEG, t_lo = (seg == nseg - 1) ? 0 : t_hi - SEG + 1;
                att::attn_unit<true>(T, b, h, qb, t_lo, t_hi, nseg > 1, slot0 + seg, (LAS char*)F.lds);
#endif
            }
#else
            {}
#endif
        }
    }
    SEAM(2);

    DBG_DUMP(2, (c < 512 ? BF(OA[(size_t)m * 512 + c]) : ((((m & 8191) >> 7) < 16 || (((c - 512) >> 7) < 2)) ? BF(OB[(size_t)m * 512 + c - 512]) : 0.f)))
    if (IN(3)) {
        {
            att::Tensors T; T.ws = ws; T.g_subln = ARG(g_subln);
            { const float a1 = wave_sum(ARG(lq1)[F.lane] * ARG(lk1)[F.lane]), a2 = wave_sum(ARG(lq2)[F.lane] * ARG(lk2)[F.lane]); T.lam = expf(a1) - expf(a2) + LAM_INIT; }
            const int wid = F.wave, lane = F.lane, r32 = lane & 31, hi = lane >> 5;
#if defined(DBG_NOSPLIT)
            for (int gi = 192; gi < 192; gi += F.G) {
#else
            for (int gi = F.vcu; gi < 192; gi += F.G) {
#endif
                const int h = 2 + (gi / 96), rr = gi % 96, b = rr / 48, qb = 16 + rr % 48;
                const int nseg = (h == 2) ? 2 : (qb >> 4) + 1;
                const int slot0 = (h == 2) ? (b * 48 + (qb - 16)) * 2 : 192 + b * 144 + (qb < 32 ? 2 * (qb - 16) : qb < 48 ? 32 + 3 * (qb - 32) : 80 + 4 * (qb - 48));
                LAS float* sc = (LAS float*)(F.lds + L_WSF) + wid * 256;
                for (int s = 0; s < nseg; ++s) { const f32x2 ml = *((const f32x2*)(T.part() + (size_t)(slot0 + s) * PART_SLOT + 8 * 64 * 64 * 4) + wid * 32 + r32);
                    if (hi == 0) { sc[(s * 32 + r32) * 2] = ml.x; sc[(s * 32 + r32) * 2 + 1] = ml.y; } }
                LDS_WAIT();
                f32x16 o[4]; float inv[16], mst[16];
#pragma unroll
                for (int g = 0; g < 4; ++g) o[g] = f32x16{};
#pragma unroll
                for (int r = 0; r < 16; ++r) { float mm = sc[(att::crow(r, hi)) * 2]; for (int s = 1; s < nseg; ++s) mm = fmaxf(mm, sc[(s * 32 + att::crow(r, hi)) * 2]); mst[r] = mm; inv[r] = 0.f; }
                for (int s = 0; s < nseg; ++s) {
                    const float* po = (const float*)(T.part() + (size_t)(slot0 + s) * PART_SLOT) + (size_t)wid * 4096;
                    float fs[16];
#pragma unroll
                    for (int r = 0; r < 16; ++r) { const int row = att::crow(r, hi); fs[r] = __builtin_amdgcn_exp2f(sc[(s * 32 + row) * 2] - mst[r]); inv[r] += fs[r] * sc[(s * 32 + row) * 2 + 1]; }
#pragma unroll
                    for (int g = 0; g < 4; ++g) {
#pragma unroll
                        for (int r = 0; r < 16; ++r) o[g][r] += fs[r] * po[(g * 16 + r) * 64 + lane];
                        asm volatile("" ::: "memory"); }
                }
#pragma unroll
                for (int r = 0; r < 16; ++r) inv[r] = __builtin_amdgcn_rcpf(inv[r]);
                att::diff_finish(o, inv, wid, lane, (LAS char*)F.lds + RING_OFF, T, b, h, qb * 128);
                __syncthreads();
            }
        }
        {
            LAS float* scr = (LAS float*)(F.lds + 65536 + F.wave * 8704);
            __syncthreads();
            constexpr int I_UP = 16 * 16, I_DN = 8 * 32, PER_E = 2 * I_UP + I_DN;
#if defined(DBG_CHECK)
            for (int it = NEXP * PER_E; it < NEXP * PER_E; it += NGW) {
#else
            for (int it = gw; it < NEXP * PER_E; it += NGW) {
#endif
                const int e = it / PER_E; int r = it % PER_E;
                if (r < 2 * I_UP) { const int sel = r / I_UP; r %= I_UP; const int kb = r / 16, nb = r % 16, n0 = 32 * nb;
                    const float* src = (sel ? ARG(w3) : ARG(w1)) + ((size_t)e * 1024 + 64 * kb) * 512 + n0;
                    const int nd = (n0 >> 7) * 256 + sel * 128 + (n0 & 127);
                    transpose_item(src, 512, Wup + ((size_t)e * 1024 + nd) * 1024 + 64 * kb, 1024, scr, F.lane);
                } else { r -= 2 * I_UP; const int kb = r / 32, nb = r % 32;
                    transpose_item(ARG(w2) + ((size_t)e * 512 + 64 * kb) * 1024 + 32 * nb, 1024, Wdn + ((size_t)e * 1024 + 32 * nb) * 512 + 64 * kb, 512, scr, F.lane); }
            }
        }
    }
    SEAM(3);

    DBG_DUMP(3, (c < 512 ? BF(OA[(size_t)m * 512 + c]) : BF(OB[(size_t)m * 512 + c - 512])))
#if defined(DBG_CHECK) && !(DBG_CHECK == 3 || DBG_CHECK == 4)
#define DBG_CHK_PH 4
    if (IN(DBG_CHK_PH)) {
        unsigned* dmax = (unsigned*)(F.ctl + 300);
        float md = 0.f;
        const int rows14[14] = {0, 31, 32, 63, 64, 100, 255, 256, 511, 1000, 2047, 4096, 5000, 8191};
        if (DBG_CHECK == 1) {
            for (int task = gw; task < 16 * 14; task += NGW) {
                const int bh = task / 14, b = bh >> 3, h = bh & 7; int i = 0;
                for (int q = 0; q < 14; ++q) if (q == task % 14) i = rows14[q];
                const bf16_t* Q = QKV + ((size_t)b * SEQ + i) * 512 + h * 64; const bf16_t* Kp = QKV + QKV_STRIDE / 2 + (size_t)b * SEQ * 512 + h * 64; const bf16_t* Vp = QKV + 2 * (QKV_STRIDE / 2) + (size_t)b * SEQ * 512 + h * 64;
                const float* fb = FB + (size_t)bh * SEQ;
                const float qd = BF(Q[F.lane]); float m = -1e30f, l = 0.f, acc = 0.f;
                for (int j = i; j >= 0; --j) { const float sc = wave_sum(qd * BF(Kp[(size_t)j * 512 + F.lane])) + fb[j];
                    const float mn = fmaxf(m, sc), f = __builtin_amdgcn_exp2f(m - mn), p = __builtin_amdgcn_exp2f(sc - mn); l = l * f + p; acc = acc * f + p * BF(Vp[(size_t)j * 512 + F.lane]); m = mn; }
                const float ref = acc / l, got = BF(OA[((size_t)b * SEQ + i) * 512 + h * 64 + F.lane]);
                md = fmaxf(md, fabsf(ref - got));
            }
        } else if (DBG_CHECK == 2) {
            const float lam = expf(wave_sum(ARG(lq1)[F.lane] * ARG(lk1)[F.lane])) - expf(wave_sum(ARG(lq2)[F.lane] * ARG(lk2)[F.lane])) + LAM_INIT;
            for (int task = gw; task < 8 * 14; task += NGW) {
                const int bh = task / 14, b = bh >> 2, h = bh & 3; int i = 0;
                for (int q = 0; q < 14; ++q) if (q == task % 14) i = rows14[q];
                const float sl2 = LOG2E * __builtin_amdgcn_exp2f(-2.0f * (float)(h + 1));
                const bf16_t* Q = QKV + 3 * (QKV_STRIDE / 2) + ((size_t)b * SEQ + i) * 512 + h * 128; const bf16_t* Kp = QKV + 4 * (QKV_STRIDE / 2) + (size_t)b * SEQ * 512 + h * 128; const bf16_t* Vp = QKV + 5 * (QKV_STRIDE / 2) + (size_t)b * SEQ * 512 + h * 128;
                const float q1 = BF(Q[F.lane]), q2 = BF(Q[64 + F.lane]); float m1 = -1e30f, l1 = 0.f, a1 = 0.f, c1 = 0.f, m2 = -1e30f, l2 = 0.f, a2 = 0.f, c2 = 0.f;
                const int jmax = (i | 63);
                const int jlo_ = ((jmax >> 6) - (DBG_NTILES - 1)) > 0 ? ((jmax >> 6) - (DBG_NTILES - 1)) * 64 : 0;
                for (int j = jmax; j >= jlo_; --j) { const float bias = -sl2 * fabsf((float)(i - j));
                    const float s1 = wave_sum(q1 * BF(Kp[(size_t)j * 512 + F.lane])) + bias, s2 = wave_sum(q2 * BF(Kp[(size_t)j * 512 + 64 + F.lane])) + bias;
                    const float va = BF(Vp[(size_t)j * 512 + F.lane]), vb = BF(Vp[(size_t)j * 512 + 64 + F.lane]);
                    { const float mn = fmaxf(m1, s1), f = __builtin_amdgcn_exp2f(m1 - mn), p = __builtin_amdgcn_exp2f(s1 - mn); l1 = l1 * f + p; a1 = a1 * f + p * va; c1 = c1 * f + p * vb; m1 = mn; }
                    { const float mn = fmaxf(m2, s2), f = __builtin_amdgcn_exp2f(m2 - mn), p = __builtin_amdgcn_exp2f(s2 - mn); l2 = l2 * f + p; a2 = a2 * f + p * va; c2 = c2 * f + p * vb; m2 = mn; } }
                const float oa_ = a1 / l1 - lam * a2 / l2, ob_ = c1 / l1 - lam * c2 / l2;
                const float rstd = 0.8f / sqrtf(wave_sum(oa_ * oa_ + ob_ * ob_) * (1.f / 128.f) + EPS);
                const float r0 = oa_ * rstd * ARG(g_subln)[F.lane], r1 = ob_ * rstd * ARG(g_subln)[64 + F.lane];
                const float g0 = BF(OB[((size_t)b * SEQ + i) * 512 + h * 128 + F.lane]), g1 = BF(OB[((size_t)b * SEQ + i) * 512 + h * 128 + 64 + F.lane]);
                if (((DBG_SELH >> h) & 1) && ((DBG_SELR >> (task % 14)) & 1)) md = fmaxf(md, fmaxf(fabsf(r0 - g0), fabsf(r1 - g1)));
            }
        } else if (DBG_CHECK == 5) {
            const float* xp = ARG(x); const float* gm = ARG(g_mix);
            for (int task = gw; task < 8 * 14; task += NGW) {
                const int bh = task / 14, b = bh >> 2, h = bh & 3; int i = 0;
                for (int q = 0; q < 14; ++q) if (q == task % 14) i = rows14[q];
                if (!(((DBG_SELH >> h) & 1) && ((DBG_SELR >> (task % 14)) & 1))) continue;
                const size_t e = ((size_t)b * SEQ + i) * 512 + h * 128 + F.lane; const int m = 8192 + (int)(e >> 10), c = (int)(e & 1023);
                float ss = 0.f; for (int k = F.lane; k < 1024; k += 64) { const float v = xp[(size_t)m * 1024 + k]; ss += v * v; }
                const float rstd = 1.0f / sqrtf(wave_sum(ss) * (1.f / DM) + EPS);
                const float xn = BF((bf16_t)f2bf(xp[(size_t)m * 1024 + c] * rstd * gm[c]));
                md = fmaxf(md, fabsf(xn - BF(OB[e])));
            }
        } else if (DBG_CHECK == 3) {
            for (int task = gw; task < 4096; task += NGW) {
                const int mrow = (task * 2654435 + 977) & (M - 1);
                for (int q = 0; q < 4; ++q) { const int n = (task * 131 + q * 1283 + F.lane * 79 + 17) % 5120;
                    float d = 0.f; for (int k = 0; k < 1024; ++k) d += BF(XN[(size_t)mrow * 1024 + k]) * BF(Win_t[(size_t)n * 1024 + k]);
                    float got, ref;
                    if (n < 3072) { const int t6 = n / 512; got = BF(QKV[(size_t)t6 * (QKV_STRIDE / 2) + (size_t)mrow * 512 + (n % 512)]); ref = d * ((t6 == 0 || t6 == 3) ? C2 : 1.f); }
                    else { const int g = (n - 3072) / 1024, gc = (n - 3072) % 1024; got = BF(GATES[(size_t)g * M * 1024 + (size_t)mrow * 1024 + gc]); ref = 1.f / (1.f + expf(-(d + ARG(b_gate)[g * 1024 + gc]))); }
                    const int cls = (n < 3072) ? (n / 512) : 6 + (n - 3072) / 1024;
                    if ((DBG_SELH >> cls) & 1) { if (fabsf(got - ref) > 0.05f) md += 1.0f; } }
            }
        } else if (DBG_CHECK == 4) {
            for (int task = gw; task < 8192; task += NGW) {
                const int n = (task * 37 + F.lane * 83) % 5120, k = (task * 91 + F.lane * 7) & 1023; const int scol = n + (n >= 1536 ? 8 : 0);
                md = fmaxf(md, fabsf(BF(Win_t[(size_t)n * 1024 + k]) - BF((bf16_t)f2bf(ARG(w_in)[(size_t)k * 5128 + scol]))));
                const int n2 = (task * 53 + F.lane * 29) & 1023, k2 = (task * 17 + F.lane * 3) & 511;
                md = fmaxf(md, fabsf(BF(Wpa_t[(size_t)n2 * 512 + k2]) - BF((bf16_t)f2bf(ARG(w_pa)[(size_t)k2 * 1024 + n2]))));
                md = fmaxf(md, fabsf(BF(Wpb_t[(size_t)n2 * 512 + k2]) - BF((bf16_t)f2bf(ARG(w_pb)[(size_t)k2 * 1024 + n2]))));
                md = fmaxf(md, fabsf(BF(Wo_t[(size_t)n2 * 1024 + k]) - BF((bf16_t)f2bf(ARG(w_o)[(size_t)k * 1024 + n2]))));
            }
        }
#if DBG_CHECK == 3
        md = wave_sum(md);
        if (F.lane == 0) atomicAdd((unsigned*)(F.ctl + 301), (unsigned)md);
        if (F.lane == 0) atomicMax(dmax, 0u);
#else
        md = wave_max(md);
        if (F.lane == 0) atomicMax(dmax, __float_as_uint(md));
#endif
        return;
    }
    if (IN(DBG_CHK_PH + 1)) { float d = __uint_as_float(__hip_atomic_load((unsigned*)(F.ctl + 300), RLX_AGENT)); if (DBG_CHECK == 3) d = 1e-3f * (float)__hip_atomic_load((unsigned*)(F.ctl + 301), RLX_AGENT); float* outp = ARG(out);
        for (int m = gw; m < M; m += NGW) for (int q = 0; q < 16; ++q) outp[(size_t)m * DM + q * 64 + F.lane] = (m == 0 && q == 0 && F.lane == 0) ? 1e4f * d : 0.f;
        return; }
    if (lo > DBG_CHK_PH + 1) return;
#endif
    if (IN(4)) {
        PolGate P; P.K = 512; P.OA = OA; P.OB = OB; P.Wpa = Wpa_t; P.Wpb = Wpb_t; P.gates = GATES; P.Y = Y; P.so.init(M, DM, F.G, (int)blockIdx.x);
        pg8::gemm_run(F.lds + RING_OFF, P);
    }
    SEAM(4);

    if (IN(5)) {
        PolWo P; P.K = DM; P.A = Y; P.Bt = Wo_t; P.x = ARG(x); P.x1 = X1; P.so.init(M, DM, F.G, (int)blockIdx.x);
        pg8::gemm_run(F.lds + RING_OFF, P);
    }
    SEAM(5);

#if defined(DBG_STAGE)
    if (DBG_STAGE == 5 && IN(6)) {
        const float* gf = ARG(g_final); float* outp = ARG(out);
        for (int m = gw; m < M; m += NGW) { float v[16]; float ss = 0.f;
#pragma unroll
            for (int q = 0; q < 16; ++q) { v[q] = X1[(size_t)m * 1024 + q * 64 + F.lane]; ss += v[q] * v[q]; }
            const float rstd = 1.0f / sqrtf(wave_sum(ss) * (1.f / DM) + EPS);
#pragma unroll
            for (int q = 0; q < 16; ++q) outp[(size_t)m * 1024 + q * 64 + F.lane] = v[q] * rstd * gf[q * 64 + F.lane]; }
        return; }
#endif
    if (IN(6)) {
        LAS float* wt = (LAS float*)(F.lds + 0);
        LAS int* hl = (LAS int*)(F.lds + MISC_OFF + 128);
        for (int i = F.tid; i < 1024 * 4; i += 512) { const int k = i >> 2, c = i & 3; wt[c * 1024 + k] = ARG(w_group)[i]; }
        for (int i = F.tid; i < 1024 * 32; i += 512) { const int k = i >> 5, c = i & 31; wt[(4 + c) * 1024 + k] = ARG(w_expert)[i]; }
        if (F.tid < 32) hl[F.tid] = 0;
        __syncthreads();
        const int wgb = (int)blockIdx.x;
        for (int tb = wgb; tb < M / 64; tb += F.G) {
            for (int rb = 0; rb < 2; ++rb) {
                const int tok0 = tb * 64 + F.wave * 8 + rb * 4;
                f32x4 hv[4][4];
#pragma unroll
                for (int rr = 0; rr < 4; ++rr) {
                    const GAS f32x4* xr = (const GAS f32x4*)(X1 + (size_t)(tok0 + rr) * DM) + F.lane; float s = 0.f;
#pragma unroll
                    for (int j = 0; j < 4; ++j) { hv[rr][j] = xr[64 * j]; s += (hv[rr][j].x * hv[rr][j].x + hv[rr][j].y * hv[rr][j].y) + (hv[rr][j].z * hv[rr][j].z + hv[rr][j].w * hv[rr][j].w); }
                    const float rstd = 1.0f / sqrtf(wave_sum(s) * (1.f / DM) + EPS);
                    GAS unsigned long long* o8 = (GAS unsigned long long*)(H2 + (size_t)(tok0 + rr) * DM) + F.lane;
#pragma unroll
                    for (int j = 0; j < 4; ++j) { const f32x4 g = *((const GAS f32x4*)ARG(g_moe) + 64 * j + F.lane); hv[rr][j] = hv[rr][j] * rstd * g;
                        o8[64 * j] = (unsigned long long)pk2(hv[rr][j].x, hv[rr][j].y) | ((unsigned long long)pk2(hv[rr][j].z, hv[rr][j].w) << 32); }
                }
                float lg[4] = {0.f, 0.f, 0.f, 0.f};
                for (int c = 0; c < 36; ++c) {
                    float p[4] = {0.f, 0.f, 0.f, 0.f};
#pragma unroll
                    for (int j = 0; j < 4; ++j) { const f32x4 w = *(const LAS f32x4*)(wt + c * 1024 + 4 * (64 * j + F.lane));
#pragma unroll
                        for (int rr = 0; rr < 4; ++rr) p[rr] += (hv[rr][j].x * w.x + hv[rr][j].y * w.y) + (hv[rr][j].z * w.z + hv[rr][j].w * w.w); }
#pragma unroll
                    for (int rr = 0; rr < 4; ++rr) { const float t_ = wave_sum(p[rr]); if (F.lane == c) lg[rr] = t_; }
                }
#pragma unroll
                for (int rr = 0; rr < 4; ++rr) {
                    float gl[4];
#pragma unroll
                    for (int g = 0; g < 4; ++g) gl[g] = __shfl(lg[rr], g) + ARG(b_group)[g];
                    int gi = 0; float gm = gl[0];
#pragma unroll
                    for (int g = 1; g < 4; ++g) if (gl[g] > gm) { gm = gl[g]; gi = g; }
                    float gs = 0.f;
#pragma unroll
                    for (int g = 0; g < 4; ++g) gs += expf(gl[g] - gm);
                    const float g_w = 1.0f / gs;
                    float el[8];
#pragma unroll
                    for (int j = 0; j < 8; ++j) el[j] = __shfl(lg[rr], 4 + gi * 8 + j) + ARG(b_expert)[gi * 8 + j];
                    int i1 = 0; float m1 = el[0];
#pragma unroll
                    for (int j = 1; j < 8; ++j) if (el[j] > m1) { m1 = el[j]; i1 = j; }
                    int i2 = -1; float m2 = -__builtin_inff();
#pragma unroll
                    for (int j = 0; j < 8; ++j) if (j != i1 && el[j] > m2) { m2 = el[j]; i2 = j; }
                    const float e2 = expf(m2 - m1), den = 1.0f / (1.0f + e2);
                    if (F.lane < 2) {
                        const int tok = tok0 + rr; const int e = gi * 8 + (F.lane == 0 ? i1 : i2); const float w_ = g_w * (F.lane == 0 ? den : e2 * den);
                        const int rank = __hip_atomic_fetch_add(&hl[e], 1, __ATOMIC_RELAXED, __HIP_MEMORY_SCOPE_WORKGROUP);
                        ASG_E[tok * 2 + F.lane] = e; ASG_W[tok * 2 + F.lane] = w_; ASG_R[tok * 2 + F.lane] = rank;
                    }
                }
            }
            __syncthreads();
            if (F.tid < 32) { HIST[tb * 32 + F.tid] = hl[F.tid]; hl[F.tid] = 0; }
            __syncthreads();
        }
    }
    SEAM(6);

    if (IN(7)) {
        LAS int* tot = (LAS int*)(F.lds + 0); LAS int* bef = tot + 32; LAS int* pst = tot + 64; LAS int* cumt = tot + 96;
        for (int tb = (int)blockIdx.x; tb < M / 64; tb += F.G) {
            __syncthreads();
            if (F.tid < 32) { int t_ = 0, b_ = 0; for (int q = 0; q < M / 64; ++q) { const int v = HIST[q * 32 + F.tid]; if (q < tb) b_ += v; t_ += v; } tot[F.tid] = t_; bef[F.tid] = b_; }
            __syncthreads();
            if (F.tid == 0) { int run = 0; for (int e = 0; e < 32; ++e) { pst[e] = run; run += (tot[e] + 255) & ~255; cumt[e] = run >> 8; } }
            __syncthreads();
            if (F.tid < 128) { const int tok = tb * 64 + (F.tid >> 1), k = F.tid & 1; const int e = ASG_E[tok * 2 + k]; const int pos = pst[e] + bef[e] + ASG_R[tok * 2 + k];
                ROW_TOK[pos] = tok; ROW_DST[pos] = tok * 2 + k; ROW_W[pos] = ASG_W[tok * 2 + k]; }
            if (tb < 32) { const int e = tb; const int p0 = pst[e] + tot[e], p1 = pst[e] + ((tot[e] + 255) & ~255);
                for (int p = p0 + F.tid; p < p1; p += 512) { ROW_TOK[p] = 0; ROW_DST[p] = -1; ROW_W[p] = 0.f; }
                const int t0 = pst[e] >> 8, t1 = cumt[e];
                for (int t_ = t0 + F.tid; t_ < t1; t_ += 512) TILE_E[t_] = e;
                if (e == 31 && F.tid == 0) TILE_E[255] = cumt[31]; }
        }
    }
    SEAM(7);

    if (IN(8)) {
        PolUp P; P.K = DM; P.H2 = H2; P.Wup = Wup; P.H = HB; P.row_tok = ROW_TOK; P.tile_e = TILE_E; P.ntiles = TILE_E[255]; P.G = F.G; P.c = F.vcu;
        pg8::gemm_run(F.lds + RING_OFF, P);
    }
    SEAM(8);

    if (IN(9)) {
        PolDown P; P.K = DEXP; P.Hb = HB; P.Wdn = Wdn; P.Yexp = YEXP; P.row_dst = ROW_DST; P.row_w = ROW_W; P.tile_e = TILE_E; P.ntiles = TILE_E[255]; P.G = F.G; P.c = F.vcu;
        pg8::gemm_run(F.lds + RING_OFF, P);
    }
    SEAM(9);

    DBG_DUMP(9, BF(YEXP[(size_t)(2 * m) * 1024 + c]) + BF(YEXP[(size_t)(2 * m + 1) * 1024 + c]))
    if (IN(10)) {
        for (int m = gw; m < M; m += NGW) {
            const GAS f32x4* xr = (const GAS f32x4*)(X1 + (size_t)m * DM) + F.lane;
            const GAS u32x2* y0 = (const GAS u32x2*)(YEXP + (size_t)(2 * m) * DM) + F.lane; const GAS u32x2* y1 = (const GAS u32x2*)(YEXP + (size_t)(2 * m + 1) * DM) + F.lane;
            f32x4 v[4]; float s = 0.f;
#pragma unroll
            for (int j = 0; j < 4; ++j) { const u32x2 a = y0[64 * j], c = y1[64 * j]; f32x4 mo; mo.x = bf_lo(a.x) + bf_lo(c.x); mo.y = bf_hi(a.x) + bf_hi(c.x); mo.z = bf_lo(a.y) + bf_lo(c.y); mo.w = bf_hi(a.y) + bf_hi(c.y);
                v[j] = xr[64 * j] + mo; s += (v[j].x * v[j].x + v[j].y * v[j].y) + (v[j].z * v[j].z + v[j].w * v[j].w); }
            const float rstd = 1.0f / sqrtf(wave_sum(s) * (1.f / DM) + EPS);
            GAS f32x4* o = (GAS f32x4*)(ARG(out) + (size_t)m * DM) + F.lane;
#pragma unroll
            for (int j = 0; j < 4; ++j) { const f32x4 g = *((const GAS f32x4*)ARG(g_final) + 64 * j + F.lane); o[64 * j] = v[j] * rstd * g; }
        }
    }
#undef IN
#undef SEAM
}

extern "C" void kernel_launch(void* const* d_in, const int* in_sizes, int n_in, void* d_out, int out_size, void* d_ws, size_t ws_size, hipStream_t stream) {
    static int grid = 0;
    if (grid == 0) {
        if (n_in != 22 || in_sizes[0] != M * DM || out_size != M * DM || ws_size < WS_END) { fprintf(stderr, "kernel_launch: unexpected shapes (n_in %d, in0 %d, out %d, ws %zu); nothing launched\n", n_in, n_in > 0 ? in_sizes[0] : -1, out_size, ws_size); grid = -1; return; }
        int dev = 0, cus = 0, per_cu = 0;
        if (hipGetDevice(&dev) != hipSuccess || hipDeviceGetAttribute(&cus, hipDeviceAttributeMultiprocessorCount, dev) != hipSuccess) { grid = -1; return; }
        if (hipFuncSetAttribute((const void*)mk_fwd, hipFuncAttributeMaxDynamicSharedMemorySize, LDS_BYTES) != hipSuccess) { fprintf(stderr, "kernel_launch: hipFuncSetAttribute failed\n"); grid = -1; return; }
        if (hipOccupancyMaxActiveBlocksPerMultiprocessor(&per_cu, (const void*)mk_fwd, NWAVES * 64, LDS_BYTES) != hipSuccess || per_cu < 1) fprintf(stderr, "kernel_launch: occupancy query reports %d\n", per_cu);
        (void)hipGetLastError();
        grid = cus;
    }
    if (grid < 0) return;
    if (hipMemsetAsync((char*)d_ws + WS_CTL, 0, CTL_ZERO_BYTES, stream) != hipSuccess) return;
    Args a{};
    a.x = (const float*)d_in[0]; a.g_mix = (const float*)d_in[1]; a.w_in = (const float*)d_in[2]; a.b_fgate = (const float*)d_in[3]; a.b_gate = (const float*)d_in[4];
    a.lq1 = (const float*)d_in[5]; a.lk1 = (const float*)d_in[6]; a.lq2 = (const float*)d_in[7]; a.lk2 = (const float*)d_in[8]; a.g_subln = (const float*)d_in[9];
    a.w_pa = (const float*)d_in[10]; a.w_pb = (const float*)d_in[11]; a.w_o = (const float*)d_in[12]; a.g_moe = (const float*)d_in[13]; a.w_group = (const float*)d_in[14]; a.b_group = (const float*)d_in[15];
    a.w_expert = (const float*)d_in[16]; a.b_expert = (const float*)d_in[17]; a.w1 = (const float*)d_in[18]; a.w3 = (const float*)d_in[19]; a.w2 = (const float*)d_in[20]; a.g_final = (const float*)d_in[21];
    a.out = (float*)d_out; a.ws = (unsigned char*)d_ws;
    if (MK_N_LAUNCHES == 1) { a.ph_lo = 0; a.ph_hi = NPH; hipLaunchKernelGGL(mk_fwd, dim3(grid), dim3(NWAVES * 64), LDS_BYTES, stream, a); }
    else for (int p = 0; p < NPH; ++p) { a.ph_lo = p; a.ph_hi = p + 1; hipLaunchKernelGGL(mk_fwd, dim3(grid), dim3(NWAVES * 64), LDS_BYTES, stream, a); }
}
```

```cpp
#include <hip/hip_runtime.h>
#include <cstdio>
#include <cstdint>

#define LAS __attribute__((address_space(3)))
#define GAS __attribute__((address_space(1)))
typedef unsigned short bf16_t;
typedef short bf16x8 __attribute__((ext_vector_type(8)));
typedef short s16x4 __attribute__((ext_vector_type(4)));
typedef float f32x4 __attribute__((ext_vector_type(4)));
typedef float f32x2 __attribute__((ext_vector_type(2)));
typedef float f32x16 __attribute__((ext_vector_type(16)));
typedef unsigned u32x4 __attribute__((ext_vector_type(4)));
typedef unsigned u32x2 __attribute__((ext_vector_type(2)));
typedef GAS unsigned gu32;

#ifndef MK_N_LAUNCHES
#define MK_N_LAUNCHES 1
#define DBG_NTILES 128
#define DBG_SELH 0x40
#define DBG_SELR 0x3fff
#endif

constexpr int BATCH = 2, SEQ = 8192, DM = 1024, M = BATCH * SEQ;
constexpr int NPROJ = 5120;
constexpr int NEXP = 32, DEXP = 512;
constexpr float EPS = 1e-6f;
constexpr float LOG2E = 1.4426950408889634f;
constexpr float C2 = 0.125f * LOG2E;
constexpr float SKIP_T = 40.0f;
constexpr int SEG = 32;
constexpr float LAM_INIT = 0.2f;

constexpr size_t MiB = 1u << 20;
constexpr size_t WS_CTL = 0, CTL_ZERO_BYTES = 1 * MiB;
constexpr size_t WS_MISC = 1 * MiB;
constexpr size_t WS_WIN = 4 * MiB, WS_WPA = 14 * MiB, WS_WPB = 15 * MiB, WS_WO = 16 * MiB;
constexpr size_t WS_C = 18 * MiB;
constexpr size_t WS_D = 50 * MiB;
constexpr size_t WS_E = 146 * MiB;
constexpr size_t WS_END = 242 * MiB;
constexpr size_t WS_OA = WS_C, WS_OB = WS_C + 16 * MiB;
constexpr size_t QKV_STRIDE = 16 * MiB;
constexpr size_t WS_UP = WS_D, WS_DN = WS_D + 64 * MiB, WS_YEXP = WS_D;
constexpr size_t WS_Y = WS_E, WS_X1 = WS_E + 32 * MiB;
constexpr size_t PART_SLOT = 8 * 64 * 64 * 4 + 8 * 32 * 8;
constexpr size_t MS_LF = 0;
constexpr size_t MS_FB = 512 * 1024;
constexpr size_t MS_UNITS = 1024 * 1024;
constexpr size_t MS_ASG = MS_UNITS + 16384;
constexpr size_t MS_HIST = MS_ASG + 3 * M * 8;
constexpr size_t MS_ROWTOK = MS_HIST + 256 * 32 * 4;
constexpr size_t MS_ROWDST = MS_ROWTOK + 40960 * 4;
constexpr size_t MS_ROWW = MS_ROWDST + 40960 * 4;
constexpr size_t MS_TILEE = MS_ROWW + 40960 * 4;
constexpr size_t MS_WR = 2 * 1024 * 1024;
static_assert(MS_TILEE + 1024 <= 2 * MiB && MS_WR + 2 * 48 * 1024 * 2 <= 3 * MiB, "misc region");
constexpr int CW_QHEAD = 64, CW_NUNITS = 128, CW_KMAX = 192  , CW_BAR = 4096;

constexpr int RING_OFF = 0, RING_BYTES = 131072;
constexpr int L_FBT = 98304;
constexpr int L_WSF = 131072;
constexpr int L_AUX = 139264;
constexpr int MISC_OFF = 147456;
constexpr int LDS_BYTES = 147456 + 512;
constexpr int NWAVES = 8;

#define RLX_AGENT __ATOMIC_RELAXED, __HIP_MEMORY_SCOPE_AGENT
#define LDS_WAIT() asm volatile("s_waitcnt lgkmcnt(0)" ::: "memory")
#define VM_WAIT() asm volatile("s_waitcnt vmcnt(0)" ::: "memory")
#define SBAR() __builtin_amdgcn_sched_barrier(0)

__device__ __forceinline__ unsigned f2bf(float f) { unsigned u = __builtin_bit_cast(unsigned, f); return (u + 0x7fffu + ((u >> 16) & 1u)) >> 16; }
__device__ __forceinline__ unsigned pk2(float lo, float hi) { return f2bf(lo) | (f2bf(hi) << 16); }
typedef __bf16 bf16x2_t __attribute__((ext_vector_type(2)));
__device__ __forceinline__ unsigned cvtpk_s(float lo, float hi) { f32x2 v = {lo, hi}; bf16x2_t b = __builtin_convertvector(v, bf16x2_t); return __builtin_bit_cast(unsigned, b); }
__device__ __forceinline__ unsigned cvt_pk_bf16(float lo, float hi) { return cvtpk_s(lo, hi); }
__device__ __forceinline__ float bf_lo(unsigned w) { return __builtin_bit_cast(float, w << 16); }
__device__ __forceinline__ float bf_hi(unsigned w) { return __builtin_bit_cast(float, w & 0xffff0000u); }
__device__ __forceinline__ float fsigmoid(float x) { return __builtin_amdgcn_rcpf(1.0f + __builtin_amdgcn_exp2f(-x * LOG2E)); }
__device__ __forceinline__ float wave_sum(float v) {
#pragma unroll
    for (int o = 1; o < 64; o <<= 1) v += __shfl_xor(v, o);
    return v;
}
__device__ __forceinline__ float wave_max(float v) {
#pragma unroll
    for (int o = 1; o < 64; o <<= 1) v = fmaxf(v, __shfl_xor(v, o));
    return v;
}
__device__ __forceinline__ void glds16(const void* gsrc, unsigned lds_dst) { unsigned keep;
    asm volatile("s_mov_b32 %0, m0\n\ts_mov_b32 m0, %2\n\ts_nop 0\n\tglobal_load_lds_dwordx4 %1, off\n\ts_mov_b32 m0, %0" : "=&s"(keep) : "v"(gsrc), "s"(lds_dst) : "memory"); }

namespace pg8 {
constexpr int BM = 256, BK = 64, HALF = 128, HTB = HALF * BK * 2, NXCD = 8, WGM = 8;
__host__ __device__ __forceinline__ int lds_byte(int r, int c) { const int st = (r >> 4) * 2 + (c >> 5), rr = r & 15, cc = c & 31, ob = rr * 64 + cc * 2; return st * 1024 + (ob ^ (((ob >> 9) & 1) << 5)); }
__host__ __device__ __forceinline__ void stage_rc(int b, int& R, int& C) { const int st = b / 1024, sb = b % 1024, swz = sb ^ (((sb >> 9) & 1) << 5); R = (st >> 1) * 16 + swz / 64; C = (st & 1) * 32 + (swz % 64) / 2; }
__host__ __device__ __forceinline__ int perm32(int rho) { const int n = rho >> 4, i = rho & 15; return 8 * (i >> 2) + 4 * n + (i & 3); }
struct Unit { int pm, pn, aux; };
struct StaticOrder {
    int nM, nN, nwg, G, c;
    __device__ void init(int M_, int N_, int G_, int c_) { nM = M_ / BM; nN = N_ / BM; nwg = nM * nN; G = G_; c = c_; }
    __device__ bool next(int i, Unit& u) const {
        const long L = (long)i * G + c; if (L >= nwg) return false;
        int wgid = (int)L; { const int q = nwg / NXCD, r = nwg % NXCD, xcd = wgid % NXCD, off = wgid / NXCD; wgid = (xcd < r ? xcd * (q + 1) : r * (q + 1) + (xcd - r) * q) + off; }
        const int nig = WGM * nN, gid = wgid / nig, fm = gid * WGM, gsz = (nM - fm) < WGM ? (nM - fm) : WGM;
        u.pm = fm + ((wgid % nig) % gsz); u.pn = (wgid % nig) / gsz; u.aux = 0; return true;
    }
};
typedef f32x4 Acc[2][2][4][2];
template <class P>
__device__ __forceinline__ void gemm_run(LAS unsigned char* lds, const P& S) {
    const int tid = threadIdx.x, wid = __builtin_amdgcn_readfirstlane(tid >> 6), lane = tid & 63, wr = wid >> 2, wc = wid & 3, fr = lane & 15, fq = lane >> 4;
    const int K = S.K, nt = K / BK;
    int rA[2], cA2[2]; unsigned voffB[2];
#pragma unroll
    for (int i = 0; i < 2; ++i) { int R, C; stage_rc(tid * 16 + i * 8192, R, C); const int Rb = P::PERM ? ((R & ~31) + perm32(R & 31)) : R;
        rA[i] = R; cA2[i] = C * 2; voffB[i] = (unsigned)(Rb * K + C) * 2u; }
    const size_t kstep = (size_t)(BK * 2);
    const size_t hstepB = (size_t)HALF * K * 2;
    const unsigned ldsw = (unsigned)wid * 1024u;
    const int aoff = lds_byte(wr * 64 + fr, fq * 8), boff = lds_byte(wc * 32 + fr, fq * 8);
#define PG8_SA(b, h) (((b) * 2 + (h)) * HTB)
#define PG8_SB(b, h) ((4 + (b) * 2 + (h)) * HTB)
#define PG8_STAGE(bufoff, gbase, voff) do { _Pragma("unroll") for (int _i = 0; _i < 2; ++_i) \
        __builtin_amdgcn_global_load_lds((const unsigned*)((const char*)(gbase) + (voff)[_i]), (LAS unsigned*)(lds + (bufoff) + ldsw + _i * 8192), 16, 0, 0); } while (0)
#define PG8_LDA(dst, b, h) do { _Pragma("unroll") for (int m = 0; m < 4; ++m) _Pragma("unroll") for (int k = 0; k < 2; ++k) dst[m][k] = *(const LAS bf16x8*)(lds + PG8_SA(b, h) + aoff + m * 2048 + k * 1024); } while (0)
#define PG8_LDB(dst, b, h) do { _Pragma("unroll") for (int n = 0; n < 2; ++n) _Pragma("unroll") for (int k = 0; k < 2; ++k) dst[n][k] = *(const LAS bf16x8*)(lds + PG8_SB(b, h) + boff + n * 2048 + k * 1024); } while (0)
#define PG8_MMA(ai, bj, At, Bt) do { __builtin_amdgcn_s_setprio(1); _Pragma("unroll") for (int m = 0; m < 4; ++m) _Pragma("unroll") for (int n = 0; n < 2; ++n) _Pragma("unroll") for (int k = 0; k < 2; ++k) \
        acc[ai][bj][m][n] = __builtin_amdgcn_mfma_f32_16x16x32_bf16(Bt[n][k], At[m][k], acc[ai][bj][m][n], 0, 0, 0); __builtin_amdgcn_s_setprio(0); } while (0)
#define PG8_WAIT_V(n) asm volatile("s_waitcnt vmcnt(" #n ")" ::: "memory")
#define PG8_WAIT_L(n) asm volatile("s_waitcnt lgkmcnt(" #n ")" ::: "memory")
#define PG8_BAR __builtin_amdgcn_s_barrier()
#define PG8_SCHED __builtin_amdgcn_sched_barrier(0)
#define PG8_ZERO() do { _Pragma("unroll") for (int a = 0; a < 2; ++a) _Pragma("unroll") for (int b = 0; b < 2; ++b) _Pragma("unroll") for (int m = 0; m < 4; ++m) _Pragma("unroll") for (int n = 0; n < 2; ++n) acc[a][b][m][n] = (f32x4){0.f, 0.f, 0.f, 0.f}; } while (0)
    Unit cur, nxt; int ui = 0;
    if (!S.next(0, cur)) return;
    Acc acc; PG8_ZERO();
    bf16x8 At[4][2], B0[2][2], B1[2][2];
    unsigned vA0[2], vA1[2], nA0[2], nA1[2];
    S.a_off(cur, rA, cA2, vA0, vA1);
    const char* cA = S.a_ptr(cur); const char* cB = S.b_ptr(cur);
    PG8_STAGE(PG8_SB(0, 0), cB, voffB); PG8_STAGE(PG8_SB(0, 1), cB + hstepB, voffB); PG8_STAGE(PG8_SA(0, 0), cA, vA0); PG8_STAGE(PG8_SA(0, 1), cA, vA1);
    if (wr == 1) PG8_BAR;
    PG8_WAIT_V(2); PG8_BAR;
    PG8_STAGE(PG8_SB(1, 0), cB + kstep, voffB); PG8_STAGE(PG8_SA(1, 0), cA + kstep, vA0); PG8_STAGE(PG8_SB(1, 1), cB + hstepB + kstep, voffB);
    PG8_WAIT_V(6); PG8_BAR;
    for (;;) {
        const bool has_next = S.next(ui + 1, nxt);
        const char* nA = cA; const char* nB = cB;
        nA0[0] = vA0[0]; nA0[1] = vA0[1]; nA1[0] = vA1[0]; nA1[1] = vA1[1];
        if (has_next) { nA = S.a_ptr(nxt); nB = S.b_ptr(nxt); S.a_off(nxt, rA, cA2, nA0, nA1); }
        for (int t = 0; t < nt; t += 2) {
            const bool last = (t == nt - 2);
            const char* a1 = cA + (size_t)(t + 1) * kstep;
            const char* a2 = last ? nA : cA + (size_t)(t + 2) * kstep; const char* b2 = last ? nB : cB + (size_t)(t + 2) * kstep;
            const char* a3 = a2 + kstep; const char* b3 = b2 + kstep;
            unsigned w0[2], w1[2];
            w0[0] = last ? nA0[0] : vA0[0]; w0[1] = last ? nA0[1] : vA0[1]; w1[0] = last ? nA1[0] : vA1[0]; w1[1] = last ? nA1[1] : vA1[1];
            PG8_LDB(B0, 0, 0); PG8_LDB(B1, 0, 1); PG8_SCHED; PG8_LDA(At, 0, 0); PG8_STAGE(PG8_SA(1, 1), a1, vA1);
            PG8_WAIT_V(8); PG8_WAIT_L(0); PG8_BAR; PG8_MMA(0, 0, At, B0); PG8_MMA(0, 1, At, B1); PG8_BAR; PG8_SCHED;
            PG8_LDA(At, 0, 1); PG8_STAGE(PG8_SB(0, 0), b2, voffB); PG8_STAGE(PG8_SB(0, 1), b2 + hstepB, voffB); PG8_STAGE(PG8_SA(0, 0), a2, w0);
            PG8_WAIT_V(8); PG8_WAIT_L(0); PG8_BAR; PG8_MMA(1, 0, At, B0); PG8_MMA(1, 1, At, B1); PG8_BAR; PG8_SCHED;
            PG8_LDB(B0, 1, 0); PG8_LDB(B1, 1, 1); PG8_SCHED; PG8_LDA(At, 1, 0); PG8_STAGE(PG8_SA(0, 1), a2, w1);
            PG8_WAIT_V(8); PG8_WAIT_L(0); PG8_BAR; PG8_MMA(0, 0, At, B0); PG8_MMA(0, 1, At, B1); PG8_BAR; PG8_SCHED;
            PG8_LDA(At, 1, 1); PG8_STAGE(PG8_SB(1, 0), b3, voffB); PG8_STAGE(PG8_SB(1, 1), b3 + hstepB, voffB); PG8_STAGE(PG8_SA(1, 0), a3, w0);
            PG8_WAIT_V(8); PG8_WAIT_L(0); PG8_BAR; PG8_MMA(1, 0, At, B0); PG8_MMA(1, 1, At, B1); PG8_BAR; PG8_SCHED;
        }
        if (wr == 0) PG8_BAR;
        S.epilogue(acc, cur, wr, wc, fr, fq);
        if (!has_next) break;
        if (!S.keep(cur)) PG8_ZERO();
        cur = nxt; cA = nA; cB = nB; vA0[0] = nA0[0]; vA0[1] = nA0[1]; vA1[0] = nA1[0]; vA1[1] = nA1[1]; ++ui;
        if (wr == 1) PG8_BAR;
    }
    PG8_WAIT_V(0);
    PG8_BAR;
#undef PG8_SA
#undef PG8_SB
#undef PG8_STAGE
#undef PG8_LDA
#undef PG8_LDB
#undef PG8_MMA
#undef PG8_WAIT_V
#undef PG8_WAIT_L
#undef PG8_BAR
#undef PG8_SCHED
#undef PG8_ZERO
}
}

#define XB_TMO      128
#define XB_XCNT(j)  (256  + 64 * (j))
#define XB_XSUB(j)  (1280 + 64 * (j))
#define XB_XGEN(j)  (2304 + 64 * (j))
#define XB_TOP      3328
#define XB_TOPGEN   3392
#define XCD_BAR_WORDS 3456
#define XB_SPIN_CAP (1u << 18)
__device__ __forceinline__ unsigned xb_ld(unsigned* p)              { return __hip_atomic_load(p, __ATOMIC_RELAXED, __HIP_MEMORY_SCOPE_AGENT); }
__device__ __forceinline__ unsigned xb_add(unsigned* p, unsigned v) { return __hip_atomic_fetch_add(p, v, __ATOMIC_RELAXED, __HIP_MEMORY_SCOPE_AGENT); }
__device__ __forceinline__ unsigned xb_xcc_id() { return (unsigned)__builtin_amdgcn_s_getreg((3 << 11) | 20) & 0xFu; }
#define XB_SPIN(cond, bar) do { unsigned _sp = 0; while (cond) { __builtin_amdgcn_s_sleep(1); \
    if ((++_sp & 255u) == 0u) { if (xb_ld(&(bar)[XB_TMO])) break; if (_sp > XB_SPIN_CAP) { atomicAdd(&(bar)[XB_TMO], 1u); break; } } } } while (0)
struct XcdBarrier { unsigned* bar; unsigned x; volatile LAS unsigned* st; };
__device__ __forceinline__ XcdBarrier xcd_barrier_post(unsigned* bar, volatile LAS unsigned* st) {
    XcdBarrier b; b.bar = bar; b.x = xb_xcc_id(); b.st = st;
    if (threadIdx.x == 0) (void)xb_add(&bar[XB_XCNT(b.x)], 1u);
    return b;
}
__device__ __forceinline__ void xcd_barrier_complete(unsigned* bar, unsigned x, unsigned& nloc, unsigned& nx) {
    const unsigned G = gridDim.x * gridDim.y * gridDim.z;
    unsigned sum, cnt, mine, sp = 0u;
    for (;;) {
        sum = 0u; cnt = 0u; mine = 0u;
#pragma unroll
        for (unsigned j = 0; j < 16; ++j) { const unsigned c = xb_ld(&bar[XB_XCNT(j)]); sum += c; cnt += (c > 0u) ? 1u : 0u; mine = (j == x) ? c : mine; }
        if (sum == G) break;
        __builtin_amdgcn_s_sleep(1);
        if ((++sp & 255u) == 0u) { if (xb_ld(&bar[XB_TMO])) break; if (sp > XB_SPIN_CAP) { atomicAdd(&bar[XB_TMO], 1u); break; } }
    }
    nloc = mine > 0u ? mine : 1u; nx = cnt > 0u ? cnt : 1u;
}
__device__ __forceinline__ void xcd_barrier(const XcdBarrier& b) {
    asm volatile("s_waitcnt vmcnt(0)" ::: "memory");
    __syncthreads();
    if (threadIdx.x == 0) {
        unsigned* bar = b.bar;
        __builtin_amdgcn_s_waitcnt(0);
        unsigned nloc = b.st[0], nx = b.st[1];
        if (nloc == 0u) { xcd_barrier_complete(bar, b.x, nloc, nx); b.st[0] = nloc; b.st[1] = nx; }
        const unsigned old = xb_add(&bar[XB_XSUB(b.x)], 1u);
        const unsigned gen = old / nloc;
        if (old + 1u == (gen + 1u) * nloc) {
            __builtin_amdgcn_fence(__ATOMIC_RELEASE, "agent");
            asm volatile("s_waitcnt vmcnt(0)" ::: "memory");
            const unsigned og = xb_add(&bar[XB_TOP], 1u);
            const unsigned tg = og / nx;
            if (og + 1u == (tg + 1u) * nx) xb_add(&bar[XB_TOPGEN], 1u);
            else XB_SPIN(xb_ld(&bar[XB_TOPGEN]) == tg, bar);
            __builtin_amdgcn_fence(__ATOMIC_ACQUIRE, "agent");
            xb_add(&bar[XB_XGEN(b.x)], 1u);
            asm volatile("s_waitcnt vmcnt(0)" ::: "memory");
        } else {
            XB_SPIN(xb_ld(&bar[XB_XGEN(b.x)]) == gen, bar);
            __builtin_amdgcn_fence(__ATOMIC_ACQUIRE, "agent");
            asm volatile("s_waitcnt vmcnt(0)" ::: "memory");
        }
    }
    __syncthreads();
}

struct Args {
    const float* x; const float* g_mix; const float* w_in; const float* b_fgate; const float* b_gate;
    const float* lq1; const float* lk1; const float* lq2; const float* lk2; const float* g_subln;
    const float* w_pa; const float* w_pb; const float* w_o; const float* g_moe; const float* w_group; const float* b_group;
    const float* w_expert; const float* b_expert; const float* w1; const float* w3; const float* w2; const float* g_final;
    float* out; unsigned char* ws; int ph_lo, ph_hi;
};
struct Frame {
    LAS unsigned char* lds; gu32* ctl; unsigned char* ws;
    int tid, lane, wave, vcu, G;
};

struct TrRegs { f32x4 v[8]; };
__device__ __forceinline__ void tr_load(TrRegs& R, const float* src  , int ldn, int lane) {
#pragma unroll
    for (int i = 0; i < 8; ++i) R.v[i] = *(const f32x4*)(src + (size_t)(8 * i + (lane >> 3)) * ldn + 4 * (lane & 7));
}
__device__ __forceinline__ void tr_store(const TrRegs& R, bf16_t* dst  , int ldk, LAS float* scr, int lane) {
#pragma unroll
    for (int i = 0; i < 8; ++i) { LAS float* p = scr + (8 * i + (lane >> 3)) * 33 + 4 * (lane & 7); p[0] = R.v[i].x; p[1] = R.v[i].y; p[2] = R.v[i].z; p[3] = R.v[i].w; }
    LDS_WAIT(); asm volatile("" ::: "memory");
    const int c = lane & 7;
#pragma unroll
    for (int j = 0; j < 4; ++j) { const int n = (lane >> 3) + 8 * j; const LAS float* s = scr + (8 * c) * 33 + n;
        u32x4 o; o.x = pk2(s[0 * 33], s[1 * 33]); o.y = pk2(s[2 * 33], s[3 * 33]); o.z = pk2(s[4 * 33], s[5 * 33]); o.w = pk2(s[6 * 33], s[7 * 33]);
        *(GAS u32x4*)(dst + (size_t)n * ldk + 8 * c) = o; }
    LDS_WAIT(); asm volatile("" ::: "memory");
}
__device__ __forceinline__ void transpose_item(const float* src, int ldn, bf16_t* dst, int ldk, LAS float* scr, int lane) { TrRegs R; tr_load(R, src, ldn, lane); tr_store(R, dst, ldk, scr, lane); }

namespace att {
__device__ __forceinline__ int crow(int r, int hi) { return (r & 3) + 8 * (r >> 2) + 4 * hi; }
typedef LAS const char* lds_cptr;
typedef short v4i16_t __attribute__((ext_vector_type(4)));
__device__ __forceinline__ s16x4 vtr(lds_cptr p) { return __builtin_bit_cast(s16x4, __builtin_amdgcn_ds_read_tr16_b64_v4i16((LAS v4i16_t*)p)); }
__device__ __forceinline__ float partner(float v) { return __shfl_xor(v, 32); }
#define ATT_WAIT_BAR(N) asm volatile("s_waitcnt vmcnt(" #N ") lgkmcnt(0)\n\ts_barrier" ::: "memory")

struct Tensors {
    unsigned char* ws; const float* g_subln; float lam;
    __device__ __forceinline__ const bf16_t* qkv(int t6) const { return (const bf16_t*)(ws + WS_D + (size_t)t6 * QKV_STRIDE); }
    __device__ __forceinline__ bf16_t* oa() const { return (bf16_t*)(ws + WS_OA); }
    __device__ __forceinline__ bf16_t* ob() const { return (bf16_t*)(ws + WS_OB); }
    __device__ __forceinline__ const float* fb() const { return (const float*)(ws + WS_MISC + MS_FB); }
    __device__ __forceinline__ const unsigned* kmax() const { return (const unsigned*)(ws + WS_CTL) + CW_KMAX; }
    __device__ __forceinline__ unsigned char* part() const { return ws + WS_E; }
};

__device__ __forceinline__ void diff_finish(f32x16 (&o)[4], const float (&inv)[16], int wid, int lane_in, LAS char* xch, const Tensors& T, int b, int h, int q0) {
    int lane = lane_in; asm volatile("" : "+v"(lane));
    const int sub = wid & 3, br = wid >> 2, r32 = lane & 31, hi = lane >> 5;
    LAS float* X = (LAS float*)xch + (size_t)sub * 4096;
    if (br == 1) {
#pragma unroll
        for (int g = 0; g < 4; ++g)
#pragma unroll
            for (int r = 0; r < 16; ++r) X[(g * 16 + r) * 64 + lane] = o[g][r] * inv[r] * (-T.lam);
    }
    asm volatile("s_waitcnt lgkmcnt(0)\n\ts_barrier" ::: "memory");
    if (br == 0) {
        float ss[16];
#pragma unroll
        for (int r = 0; r < 16; ++r) ss[r] = 0.f;
#pragma unroll
        for (int g = 0; g < 4; ++g) {
#pragma unroll
            for (int r = 0; r < 16; ++r) { const float v = o[g][r] * inv[r] + X[(g * 16 + r) * 64 + lane]; o[g][r] = v; ss[r] += v * v; }
            asm volatile("" ::: "memory"); }
#pragma unroll
        for (int r = 0; r < 16; ++r) {
            float s = ss[r];
#pragma unroll
            for (int off = 1; off < 32; off <<= 1) s += __shfl_xor(s, off);
            ss[r] = 0.8f * __builtin_amdgcn_rsqf(s * (1.0f / 128.0f) + EPS);
        }
        bf16_t* Ob = T.ob() + ((size_t)b * SEQ + q0 + 32 * sub) * 512 + h * 128;
#pragma unroll
        for (int g = 0; g < 4; ++g) { const float gs = T.g_subln[32 * g + r32];
#pragma unroll
            for (int r = 0; r < 16; ++r) Ob[(size_t)crow(r, hi) * 512 + 32 * g + r32] = (bf16_t)f2bf(o[g][r] * ss[r] * gs); }
    }
}

template <bool DIFF>
__device__ __forceinline__ void attn_unit(const Tensors& T, int b, int h, int qb, int t_lo, int t_hi, bool partial, int slot, LAS char* lds) {
    constexpr int NG = DIFF ? 4 : 2;
    constexpr int KBYTES = DIFF ? 16384 : 8192, STAGE = DIFF ? 32768 : 16384, NPW = DIFF ? 4 : 2;
    int tid_ = threadIdx.x; asm volatile("" : "+v"(tid_));
    const int tid = tid_, lane = tid & 63, r32 = lane & 31, hi = lane >> 5; const int wid = __builtin_amdgcn_readfirstlane(tid >> 6);
    const int sub = DIFF ? (wid & 3) : wid, br = DIFF ? (wid >> 2) : 0;
    const int q0 = DIFF ? qb * 128 : qb * 256;
    const int c_first = q0 >> 6;
    const int c_w = (q0 + 32 * sub) >> 6;
    const int irow = q0 + 32 * sub + r32;
    const size_t rowbase = (size_t)b * SEQ;
    const bf16_t* Qw = T.qkv(DIFF ? 3 : 0) + (rowbase + q0 + 32 * sub) * 512 + (DIFF ? h * 128 + br * 64 : h * 64);
    const bf16_t* Kh = T.qkv(DIFF ? 4 : 1) + rowbase * 512 + (DIFF ? h * 128 : h * 64);
    const bf16_t* Vh = T.qkv(DIFF ? 5 : 2) + rowbase * 512 + (DIFF ? h * 128 : h * 64);
    const unsigned lds0 = (unsigned)(uintptr_t)lds;
    LAS float* wsf = (LAS float*)(lds + L_WSF) + wid * 64;
    LAS float* needs = (LAS float*)(lds + L_AUX);
    const float sl2 = DIFF ? LOG2E * __builtin_amdgcn_exp2f(-2.0f * (float)(h + 1)) : 0.f;
    const bf16_t* ksrc0 = Kh + (size_t)lane * 512 + wid * 8;
    const bf16_t* vsrc0 = Vh + (size_t)(16 * (wid & 3) + (lane >> 2)) * 512 + (wid >> 2) * 32 + (lane & 3) * 8;
#define ATT_ISSUE(t, so) do { const size_t ko_ = (size_t)(t) * 64 * 512; \
        glds16(ksrc0 + ko_, (unsigned)__builtin_amdgcn_readfirstlane(lds0 + (so) + wid * 1024)); \
        glds16(vsrc0 + ko_, (unsigned)__builtin_amdgcn_readfirstlane(lds0 + (so) + KBYTES + wid * 1024)); \
        if (DIFF) { glds16(ksrc0 + ko_ + 64, (unsigned)__builtin_amdgcn_readfirstlane(lds0 + (so) + (wid + 8) * 1024)); \
                    glds16(vsrc0 + ko_ + 64, (unsigned)__builtin_amdgcn_readfirstlane(lds0 + (so) + KBYTES + (wid + 8) * 1024)); } } while (0)
    if (!DIFF) {
        const float* fb = T.fb() + (size_t)(b * 8 + h) * SEQ; LAS float* fbt = (LAS float*)(lds + L_FBT);
        const int nk4 = 16 * (t_hi + 1);
#pragma unroll 1
        for (int i = tid; i < nk4; i += 512) *(LAS f32x4*)(fbt + 4 * i) = *(const f32x4*)(fb + 4 * i);
    }
    const int nsteps = t_hi - t_lo + 1;
    ATT_ISSUE(t_hi, 0);
    if (nsteps > 1) ATT_ISSUE(t_hi - 1, STAGE);
    bf16x8 qr[4];
#pragma unroll
    for (int d0 = 0; d0 < 4; ++d0) qr[d0] = *reinterpret_cast<const bf16x8*>(&Qw[(size_t)r32 * 512 + d0 * 16 + hi * 8]);
    float qq = 0.f;
#pragma unroll
    for (int d0 = 0; d0 < 4; ++d0)
#pragma unroll
        for (int e = 0; e < 8; ++e) { const float v = __builtin_bit_cast(float, ((unsigned)(unsigned short)qr[d0][e]) << 16); qq += v * v; }
    qq += partner(qq);
    const int vh = DIFF ? 8 + 2 * h + br : h;
    const float k2 = __uint_as_float(T.kmax()[(b * 16 + vh) * 2]) + __uint_as_float(T.kmax()[(b * 16 + vh) * 2 + 1]);
    const float smax = 1.02f * sqrtf(qq * k2) + 0.05f;
    float mhat = 0.f, l_reg = 0.f; bool started = false;
    f32x16 o[NG];
#pragma unroll
    for (int g = 0; g < NG; ++g) o[g] = f32x16{};
    int sl_cur = 0, sl_n1 = STAGE, sl_n2 = 2 * STAGE;
    float need_alt = 0.f;
    const lds_cptr L3 = (lds_cptr)lds;
    for (int j = 0; j < nsteps; ++j) {
        const int t = t_hi - j;
        if (j + 1 < nsteps) { if constexpr (DIFF) { ATT_WAIT_BAR(4); } else { ATT_WAIT_BAR(2); } } else { ATT_WAIT_BAR(0); }
        if (j == 0) {
            const float bii = DIFF ? sl2 * (float)irow : ((LAS const float*)(lds + L_FBT))[irow];
            need_alt = 2.f * smax - bii;
            float nw = need_alt; nw = fmaxf(nw, partner(nw));
#pragma unroll
            for (int off = 1; off < 32; off <<= 1) nw = fmaxf(nw, __shfl_xor(nw, off));
            if (lane == 0) { needs[wid] = nw; needs[8 + wid] = nw; }
        } else {
            const LAS float* nd = needs + ((j & 1) ? 8 : 0);
            float nm = nd[0];
#pragma unroll
            for (int w = 1; w < 8; ++w) nm = fmaxf(nm, nd[w]);
            const float bmax = DIFF ? sl2 * (float)(64 * t + 63) : ((LAS const float*)(lds + L_FBT))[64 * t + 63];
            if (t < c_first && nm + bmax < -SKIP_T) break;
        }
        if (j + 2 < nsteps) ATT_ISSUE(t - 2, sl_n2);
        float need_w = need_alt;
        if (t <= c_w) {
            const bool diag = (t == c_w);
            f32x16 p0, p1;
            float sl2v = sl2; asm volatile("" : "+v"(sl2v));
            if (!DIFF) {
                const LAS float* fbt = (LAS const float*)(lds + L_FBT) + 64 * t + 4 * hi;
#pragma unroll
                for (int g4 = 0; g4 < 4; ++g4) { const f32x4 a = *(const LAS f32x4*)(fbt + 8 * g4), c = *(const LAS f32x4*)(fbt + 32 + 8 * g4);
#pragma unroll
                    for (int i = 0; i < 4; ++i) { p0[4 * g4 + i] = a[i] - mhat; p1[4 * g4 + i] = c[i] - mhat; } }
            } else if (!diag) {
                const float base = sl2v * (float)(64 * t + 4 * hi) - mhat;
#pragma unroll
                for (int r = 0; r < 16; ++r) { p0[r] = base + sl2v * (float)((r & 3) + 8 * (r >> 2)); p1[r] = p0[r] + 32.f * sl2v; }
            } else {
#pragma unroll
                for (int r = 0; r < 16; ++r) { const int jk = 64 * t + crow(r, hi);
                    const int d0_ = irow - jk, d1_ = irow - (jk + 32);
                    p0[r] = sl2v * (float)(irow - (d0_ < 0 ? -d0_ : d0_)) - mhat; p1[r] = sl2v * (float)(irow - (d1_ < 0 ? -d1_ : d1_)) - mhat; }
            }
            { const lds_cptr kb = L3 + sl_cur + (DIFF ? br * 8192 : 0) + hi * 1024 + r32 * 16;
#pragma unroll
              for (int d0 = 0; d0 < 4; ++d0) {
                  const bf16x8 b0 = *(const LAS bf16x8*)(kb + d0 * 2048), b1 = *(const LAS bf16x8*)(kb + d0 * 2048 + 512);
                  p0 = __builtin_amdgcn_mfma_f32_32x32x16_bf16(b0, qr[d0], p0, 0, 0, 0); p1 = __builtin_amdgcn_mfma_f32_32x32x16_bf16(b1, qr[d0], p1, 0, 0, 0);
                  if (d0 == 1) asm volatile("" ::: "memory"); } }
            if (!DIFF && diag) {
                const int qrel = 32 * (sub & 1) + r32;
#pragma unroll
                for (int r = 0; r < 16; ++r) { const int kv = crow(r, hi); if (kv > qrel) p0[r] = -__builtin_inff(); if (kv + 32 > qrel) p1[r] = -__builtin_inff(); }
            }
            float rm = fmaxf(p0[0], p1[0]);
#pragma unroll
            for (int r = 1; r < 16; ++r) rm = fmaxf(rm, fmaxf(p0[r], p1[r]));
            rm = fmaxf(rm, partner(rm));
            bool resc = false; float fsc = 1.f;
            if (!started) { mhat = rm;
#pragma unroll
                for (int r = 0; r < 16; ++r) { p0[r] -= rm; p1[r] -= rm; }
                started = true;
            } else if (__any(rm > 6.0f)) { const float dl = fmaxf(rm, 0.f); mhat += dl;
#pragma unroll
                for (int r = 0; r < 16; ++r) { p0[r] -= dl; p1[r] -= dl; }
                fsc = __builtin_amdgcn_exp2f(-dl); l_reg *= fsc; resc = true;
            }
            if (resc) {
                if (hi == 0) wsf[r32] = fsc;
                LDS_WAIT();
#pragma unroll
                for (int r = 0; r < 16; ++r) { const float f = wsf[crow(r, hi)];
#pragma unroll
                    for (int g = 0; g < NG; ++g) o[g][r] *= f; }
            }
            float sacc = 0.f;
#pragma unroll
            for (int r = 0; r < 16; ++r) { p0[r] = __builtin_amdgcn_exp2f(p0[r]); p1[r] = __builtin_amdgcn_exp2f(p1[r]); sacc += p0[r] + p1[r]; }
            l_reg += sacc;
            u32x4 pw0, pw1, pw2, pw3;
            pw0 = (u32x4){cvtpk_s(p0[0], p0[1]), cvtpk_s(p0[2], p0[3]), cvtpk_s(p0[4], p0[5]), cvtpk_s(p0[6], p0[7])};
            pw1 = (u32x4){cvtpk_s(p0[8], p0[9]), cvtpk_s(p0[10], p0[11]), cvtpk_s(p0[12], p0[13]), cvtpk_s(p0[14], p0[15])};
            pw2 = (u32x4){cvtpk_s(p1[0], p1[1]), cvtpk_s(p1[2], p1[3]), cvtpk_s(p1[4], p1[5]), cvtpk_s(p1[6], p1[7])};
            pw3 = (u32x4){cvtpk_s(p1[8], p1[9]), cvtpk_s(p1[10], p1[11]), cvtpk_s(p1[12], p1[13]), cvtpk_s(p1[14], p1[15])};
            { const lds_cptr vp = L3 + sl_cur + KBYTES + ((lane >> 4) & 1) * 32 + (lane & 3) * 8 + (4 * hi + ((lane & 15) >> 2)) * 64;
#pragma unroll
              for (int g = 0; g < NG; ++g) {
                  s16x4 lo[4], hh[4];
#pragma unroll
                  for (int ks = 0; ks < 4; ++ks) { lo[ks] = vtr(vp + g * 4096 + ks * 1024); hh[ks] = vtr(vp + g * 4096 + ks * 1024 + 512); }
#define ATT_PK(k) (bf16x8){lo[k][0], lo[k][1], lo[k][2], lo[k][3], hh[k][0], hh[k][1], hh[k][2], hh[k][3]}
                  o[g] = __builtin_amdgcn_mfma_f32_32x32x16_bf16(__builtin_bit_cast(bf16x8, pw0), ATT_PK(0), o[g], 0, 0, 0);
                  o[g] = __builtin_amdgcn_mfma_f32_32x32x16_bf16(__builtin_bit_cast(bf16x8, pw1), ATT_PK(1), o[g], 0, 0, 0);
                  o[g] = __builtin_amdgcn_mfma_f32_32x32x16_bf16(__builtin_bit_cast(bf16x8, pw2), ATT_PK(2), o[g], 0, 0, 0);
                  o[g] = __builtin_amdgcn_mfma_f32_32x32x16_bf16(__builtin_bit_cast(bf16x8, pw3), ATT_PK(3), o[g], 0, 0, 0);
#undef ATT_PK
                  asm volatile("" ::: "memory");
              } }
            need_w = fminf(need_alt, smax - mhat);
        }
        { float nw = need_w; nw = fmaxf(nw, partner(nw));
#pragma unroll
          for (int off = 1; off < 32; off <<= 1) nw = fmaxf(nw, __shfl_xor(nw, off));
          if (lane == 0) needs[((j + 1) & 1) ? 8 + wid : wid] = nw; }
        { const int tmp = sl_cur; sl_cur = sl_n1; sl_n1 = sl_n2; sl_n2 = tmp; }
    }
    ATT_WAIT_BAR(0);
#undef ATT_ISSUE
    int lane_e = lane; asm volatile("" : "+v"(lane_e)); const int r32e = lane_e & 31, hie = lane_e >> 5;
    const float lsum = l_reg + partner(l_reg);
    if (DIFF && partial) {
        float* po = (float*)(T.part() + (size_t)slot * PART_SLOT) + (size_t)wid * 4096;
#pragma unroll
        for (int g = 0; g < NG; ++g)
#pragma unroll
            for (int r = 0; r < 16; ++r) po[(g * 16 + r) * 64 + lane_e] = o[g][r];
        if (hie == 0) { f32x2* pml = (f32x2*)(T.part() + (size_t)slot * PART_SLOT + 8 * 64 * 64 * 4) + wid * 32 + r32e; *pml = (f32x2){mhat, lsum}; }
        return;
    }
    if (hie == 0) wsf[r32e] = lsum;
    LDS_WAIT();
    float inv[16];
#pragma unroll
    for (int r = 0; r < 16; ++r) inv[r] = __builtin_amdgcn_rcpf(wsf[crow(r, hie)]);
    if (!DIFF) {
        bf16_t* Ow = T.oa() + (rowbase + q0 + 32 * sub) * 512 + h * 64;
#pragma unroll
        for (int g = 0; g < NG; ++g)
#pragma unroll
            for (int r = 0; r < 16; ++r) Ow[(size_t)crow(r, hie) * 512 + 32 * g + r32e] = (bf16_t)f2bf(o[g][r] * inv[r]);
    } else {
        if constexpr (DIFF) diff_finish(o, inv, wid, lane_e, lds + RING_OFF, T, b, h, q0);
    }
}

__device__ __forceinline__ void decode_unit(int idx, unsigned& desc, unsigned& slot, int& cost) {
    if (idx < 512) { const int b = idx >> 8, h = (idx >> 5) & 7, qb = idx & 31; desc = 0u | (b << 1) | (h << 2) | (qb << 5) | (1u << 14); slot = 0; const int nt = 4 * qb + 4; cost = (nt < 11 ? nt : 11) * 2 / 3; return; }
    int r = idx - 512; const int b = r / 400; r -= b * 400;
    int h, qb, seg = 0, nseg = 1; slot = 0;
    if (r < 64) { h = 0; qb = r; }
    else if (r < 128) { h = 1; qb = r - 64; }
    else if (r < 240) { h = 2; const int r2 = r - 128; if (r2 < 16) qb = r2; else { qb = 16 + ((r2 - 16) >> 1); seg = (r2 - 16) & 1; nseg = 2; slot = (b * 48 + (qb - 16)) * 2; } }
    else { h = 3; const int r3 = r - 240;
        if (r3 < 16) qb = r3;
        else if (r3 < 48) { qb = 16 + ((r3 - 16) >> 1); seg = (r3 - 16) & 1; nseg = 2; slot = 192 + b * 144 + 2 * (qb - 16); }
        else if (r3 < 96) { qb = 32 + (r3 - 48) / 3; seg = (r3 - 48) % 3; nseg = 3; slot = 192 + b * 144 + 32 + 3 * (qb - 32); }
        else { qb = 48 + ((r3 - 96) >> 2); seg = (r3 - 96) & 3; nseg = 4; slot = 192 + b * 144 + 80 + 4 * (qb - 48); } }
    desc = 1u | (b << 1) | (h << 2) | (qb << 5) | (seg << 11) | (nseg << 14);
    const int ntl = 2 * qb + 2, t_hi = ntl - 1 - seg * SEG, t_lo = (seg == nseg - 1) ? 0 : t_hi - SEG + 1; int len = t_hi - t_lo + 1;
    const int win = (h == 0) ? 5 : (h == 1) ? 14 : (h == 2) ? (seg == 0 ? 32 : 18) : 32;
    cost = len < win ? len : win;
}
constexpr int NUNITS = 512 + 2 * 400;
}

struct PolBase {
    int K;
    __device__ __forceinline__ void a_off_plain(const int (&rA)[2], const int (&cA2)[2], unsigned (&v0)[2], unsigned (&v1)[2]) const {
#pragma unroll
        for (int i = 0; i < 2; ++i) { v0[i] = (unsigned)(rA[i] * K * 2 + cA2[i]); v1[i] = v0[i] + (unsigned)(128 * K * 2); }
    }
};
struct PolInProj : PolBase {
    static constexpr bool PERM = true;
    const bf16_t* A; const bf16_t* Bt; pg8::StaticOrder so; bf16_t* qkv; bf16_t* gates; const float* b_gate; unsigned* kmax;
    __device__ __forceinline__ bool next(int i, pg8::Unit& u) const { return so.next(i, u); }
    __device__ __forceinline__ const char* a_ptr(const pg8::Unit& u) const { return (const char*)(A + (size_t)u.pm * 256 * K); }
    __device__ __forceinline__ const char* b_ptr(const pg8::Unit& u) const { return (const char*)(Bt + (size_t)u.pn * 256 * K); }
    __device__ __forceinline__ void a_off(const pg8::Unit&, const int (&rA)[2], const int (&cA2)[2], unsigned (&v0)[2], unsigned (&v1)[2]) const { a_off_plain(rA, cA2, v0, v1); }
    __device__ __forceinline__ bool keep(const pg8::Unit&) const { return false; }
    __device__ __forceinline__ void epilogue(pg8::Acc& acc, const pg8::Unit& u, int wr, int wc, int fr, int fq) const {
        const int row0 = u.pm * 256 + wr * 64 + fr, colw = wc * 32 + 8 * fq;
        if (u.pn < 12) {
            const int t6 = u.pn >> 1;
            bf16_t* base = qkv + (size_t)t6 * (QKV_STRIDE / 2) + (u.pn & 1) * 256 + colw;
            const float sc = (t6 == 0 || t6 == 3) ? C2 : 1.f;
            float kq[2] = {0.f, 0.f};
#pragma unroll
            for (int ai = 0; ai < 2; ++ai)
#pragma unroll
                for (int m = 0; m < 4; ++m) { bf16_t* rowp = base + (size_t)(row0 + ai * 128 + m * 16) * 512;
#pragma unroll
                    for (int bj = 0; bj < 2; ++bj) { const f32x4 v0 = acc[ai][bj][m][0] * sc, v1 = acc[ai][bj][m][1] * sc;
                        u32x4 w; w.x = cvt_pk_bf16(v0[0], v0[1]); w.y = cvt_pk_bf16(v0[2], v0[3]); w.z = cvt_pk_bf16(v1[0], v1[1]); w.w = cvt_pk_bf16(v1[2], v1[3]);
                        *(u32x4*)(rowp + bj * 128) = w;
                        if (t6 == 1 || t6 == 4) { float s = (v0[0] * v0[0] + v0[1] * v0[1]) + (v0[2] * v0[2] + v0[3] * v0[3]) + (v1[0] * v1[0] + v1[1] * v1[1]) + (v1[2] * v1[2] + v1[3] * v1[3]);
                            s += __shfl_xor(s, 16); s += __shfl_xor(s, 32); kq[bj] = fmaxf(kq[bj], s); } } }
            if (t6 == 1 || t6 == 4) {
#pragma unroll
                for (int bj = 0; bj < 2; ++bj) { float s = kq[bj];
#pragma unroll
                    for (int off = 1; off < 16; off <<= 1) s = fmaxf(s, __shfl_xor(s, off));
                    const int vhead = (t6 == 1 ? 0 : 8) + (u.pn & 1) * 4 + 2 * bj + (wc >> 1), bb = u.pm >> 5;
                    if ((threadIdx.x & 63) == 0) atomicMax(kmax + (bb * 16 + vhead) * 2 + (wc & 1), __float_as_uint(s * 1.01f)); }
            }
        } else {
            const int g = (u.pn - 12) >> 2, gcol = ((u.pn - 12) & 3) * 256 + colw;
            bf16_t* base = gates + (size_t)g * ((size_t)M * 1024) + gcol; const float* bias = b_gate + g * 1024 + gcol;
            f32x4 bv[2][2];
#pragma unroll
            for (int bj = 0; bj < 2; ++bj)
#pragma unroll
                for (int n = 0; n < 2; ++n) bv[bj][n] = *(const f32x4*)(bias + bj * 128 + 4 * n);
#pragma unroll
            for (int ai = 0; ai < 2; ++ai)
#pragma unroll
                for (int m = 0; m < 4; ++m) { bf16_t* rowp = base + (size_t)(row0 + ai * 128 + m * 16) * 1024;
#pragma unroll
                    for (int bj = 0; bj < 2; ++bj) { const f32x4 v0 = acc[ai][bj][m][0] + bv[bj][0], v1 = acc[ai][bj][m][1] + bv[bj][1];
                        u32x4 w; w.x = cvt_pk_bf16(fsigmoid(v0[0]), fsigmoid(v0[1])); w.y = cvt_pk_bf16(fsigmoid(v0[2]), fsigmoid(v0[3]));
                        w.z = cvt_pk_bf16(fsigmoid(v1[0]), fsigmoid(v1[1])); w.w = cvt_pk_bf16(fsigmoid(v1[2]), fsigmoid(v1[3]));
                        *(u32x4*)(rowp + bj * 128) = w; } }
        }
    }
};
struct PolGate : PolBase {
    static constexpr bool PERM = true;
    const bf16_t *OA, *OB, *Wpa, *Wpb; const bf16_t* gates; bf16_t* Y; pg8::StaticOrder so;
    __device__ __forceinline__ bool next(int i, pg8::Unit& u) const { if (!so.next(i >> 1, u)) return false; u.aux = i & 1; return true; }
    __device__ __forceinline__ const char* a_ptr(const pg8::Unit& u) const { return (const char*)((u.aux ? OB : OA) + (size_t)u.pm * 256 * K); }
    __device__ __forceinline__ const char* b_ptr(const pg8::Unit& u) const { return (const char*)((u.aux ? Wpb : Wpa) + (size_t)u.pn * 256 * K); }
    __device__ __forceinline__ void a_off(const pg8::Unit&, const int (&rA)[2], const int (&cA2)[2], unsigned (&v0)[2], unsigned (&v1)[2]) const { a_off_plain(rA, cA2, v0, v1); }
    __device__ __forceinline__ bool keep(const pg8::Unit& u) const { return u.aux == 0; }
    __device__ __forceinline__ void epilogue(pg8::Acc& acc, const pg8::Unit& u, int wr, int wc, int fr, int fq) const {
        const int row0 = u.pm * 256 + wr * 64 + fr, col0 = u.pn * 256 + wc * 32 + 8 * fq;
        const bf16_t* ga = gates + col0; const bf16_t* gb = gates + (size_t)M * 1024 + col0;
#pragma unroll
        for (int ai = 0; ai < 2; ++ai)
#pragma unroll
            for (int m = 0; m < 4; ++m) { const size_t ro = (size_t)(row0 + ai * 128 + m * 16) * 1024;
#pragma unroll
                for (int bj = 0; bj < 2; ++bj) {
                    const u32x4 b = *(const u32x4*)(gb + ro + bj * 128);
                    if (u.aux == 0) {
                        const u32x4 a = *(const u32x4*)(ga + ro + bj * 128);
                        f32x4 r0, r1;
                        r0[0] = bf_lo(a.x) * __builtin_amdgcn_rcpf(fmaxf(bf_lo(b.x), 1e-30f)); r0[1] = bf_hi(a.x) * __builtin_amdgcn_rcpf(fmaxf(bf_hi(b.x), 1e-30f));
                        r0[2] = bf_lo(a.y) * __builtin_amdgcn_rcpf(fmaxf(bf_lo(b.y), 1e-30f)); r0[3] = bf_hi(a.y) * __builtin_amdgcn_rcpf(fmaxf(bf_hi(b.y), 1e-30f));
                        r1[0] = bf_lo(a.z) * __builtin_amdgcn_rcpf(fmaxf(bf_lo(b.z), 1e-30f)); r1[1] = bf_hi(a.z) * __builtin_amdgcn_rcpf(fmaxf(bf_hi(b.z), 1e-30f));
                        r1[2] = bf_lo(a.w) * __builtin_amdgcn_rcpf(fmaxf(bf_lo(b.w), 1e-30f)); r1[3] = bf_hi(a.w) * __builtin_amdgcn_rcpf(fmaxf(bf_hi(b.w), 1e-30f));
                        acc[ai][bj][m][0] *= r0; acc[ai][bj][m][1] *= r1;
                    } else {
                        const f32x4 v0 = acc[ai][bj][m][0], v1 = acc[ai][bj][m][1];
                        u32x4 w; w.x = cvt_pk_bf16(v0[0] * bf_lo(b.x), v0[1] * bf_hi(b.x)); w.y = cvt_pk_bf16(v0[2] * bf_lo(b.y), v0[3] * bf_hi(b.y));
                        w.z = cvt_pk_bf16(v1[0] * bf_lo(b.z), v1[1] * bf_hi(b.z)); w.w = cvt_pk_bf16(v1[2] * bf_lo(b.w), v1[3] * bf_hi(b.w));
                        *(u32x4*)(Y + ro + col0 + bj * 128) = w;
                    } } }
    }
};
struct PolWo : PolBase {
    static constexpr bool PERM = false;
    const bf16_t* A; const bf16_t* Bt; const float* x; float* x1; pg8::StaticOrder so;
    __device__ __forceinline__ bool next(int i, pg8::Unit& u) const { return so.next(i, u); }
    __device__ __forceinline__ const char* a_ptr(const pg8::Unit& u) const { return (const char*)(A + (size_t)u.pm * 256 * K); }
    __device__ __forceinline__ const char* b_ptr(const pg8::Unit& u) const { return (const char*)(Bt + (size_t)u.pn * 256 * K); }
    __device__ __forceinline__ void a_off(const pg8::Unit&, const int (&rA)[2], const int (&cA2)[2], unsigned (&v0)[2], unsigned (&v1)[2]) const { a_off_plain(rA, cA2, v0, v1); }
    __device__ __forceinline__ bool keep(const pg8::Unit&) const { return false; }
    __device__ __forceinline__ void epilogue(pg8::Acc& acc, const pg8::Unit& u, int wr, int wc, int fr, int fq) const {
        const int row0 = u.pm * 256 + wr * 64 + fr, col0 = u.pn * 256 + wc * 32 + 4 * fq;
#pragma unroll
        for (int ai = 0; ai < 2; ++ai)
#pragma unroll
            for (int m = 0; m < 4; ++m) { const size_t off = (size_t)(row0 + ai * 128 + m * 16) * 1024 + col0;
#pragma unroll
                for (int bj = 0; bj < 2; ++bj)
#pragma unroll
                    for (int n = 0; n < 2; ++n) { const f32x4 bs = *(const f32x4*)(x + off + bj * 128 + n * 16); *(f32x4*)(x1 + off + bj * 128 + n * 16) = bs + acc[ai][bj][m][n]; } }
    }
};
struct PolUp : PolBase {
    static constexpr bool PERM = true;
    const bf16_t* H2; const bf16_t* Wup; bf16_t* H; const int* row_tok; const int* tile_e; int ntiles, G, c;
    __device__ __forceinline__ bool next(int i, pg8::Unit& u) const { const int L = i * G + c; const int tile = L >> 2; if (tile >= ntiles) return false; u.pm = tile; u.pn = L & 3; u.aux = tile_e[tile]; return true; }
    __device__ __forceinline__ const char* a_ptr(const pg8::Unit&) const { return (const char*)H2; }
    __device__ __forceinline__ const char* b_ptr(const pg8::Unit& u) const { return (const char*)(Wup + ((size_t)u.aux * 1024 + (size_t)u.pn * 256) * 1024); }
    __device__ __forceinline__ void a_off(const pg8::Unit& u, const int (&rA)[2], const int (&cA2)[2], unsigned (&v0)[2], unsigned (&v1)[2]) const {
#pragma unroll
        for (int i = 0; i < 2; ++i) { const int t0 = row_tok[u.pm * 256 + rA[i]], t1 = row_tok[u.pm * 256 + 128 + rA[i]];
            v0[i] = (unsigned)(t0 * 2048 + cA2[i]); v1[i] = (unsigned)(t1 * 2048 + cA2[i]); }
    }
    __device__ __forceinline__ bool keep(const pg8::Unit&) const { return false; }
    __device__ __forceinline__ void epilogue(pg8::Acc& acc, const pg8::Unit& u, int wr, int wc, int fr, int fq) const {
        const int row0 = u.pm * 256 + wr * 64 + fr, col0 = u.pn * 128 + wc * 32 + 8 * fq;
#pragma unroll
        for (int ai = 0; ai < 2; ++ai)
#pragma unroll
            for (int m = 0; m < 4; ++m) { bf16_t* rowp = H + (size_t)(row0 + ai * 128 + m * 16) * 512 + col0;
                const f32x4 a0 = acc[ai][0][m][0], a1 = acc[ai][0][m][1], g0 = acc[ai][1][m][0], g1 = acc[ai][1][m][1];
                u32x4 w;
                w.x = cvt_pk_bf16(a0[0] * fsigmoid(a0[0]) * g0[0], a0[1] * fsigmoid(a0[1]) * g0[1]); w.y = cvt_pk_bf16(a0[2] * fsigmoid(a0[2]) * g0[2], a0[3] * fsigmoid(a0[3]) * g0[3]);
                w.z = cvt_pk_bf16(a1[0] * fsigmoid(a1[0]) * g1[0], a1[1] * fsigmoid(a1[1]) * g1[1]); w.w = cvt_pk_bf16(a1[2] * fsigmoid(a1[2]) * g1[2], a1[3] * fsigmoid(a1[3]) * g1[3]);
                *(u32x4*)rowp = w; }
    }
};
struct PolDown : PolBase {
    static constexpr bool PERM = true;
    const bf16_t* Hb; const bf16_t* Wdn; bf16_t* Yexp; const int* row_dst; const float* row_w; const int* tile_e; int ntiles, G, c;
    __device__ __forceinline__ bool next(int i, pg8::Unit& u) const { const int L = i * G + c; const int tile = L >> 2; if (tile >= ntiles) return false; u.pm = tile; u.pn = L & 3; u.aux = tile_e[tile]; return true; }
    __device__ __forceinline__ const char* a_ptr(const pg8::Unit& u) const { return (const char*)(Hb + (size_t)u.pm * 256 * K); }
    __device__ __forceinline__ const char* b_ptr(const pg8::Unit& u) const { return (const char*)(Wdn + ((size_t)u.aux * 1024 + (size_t)u.pn * 256) * 512); }
    __device__ __forceinline__ void a_off(const pg8::Unit&, const int (&rA)[2], const int (&cA2)[2], unsigned (&v0)[2], unsigned (&v1)[2]) const { a_off_plain(rA, cA2, v0, v1); }
    __device__ __forceinline__ bool keep(const pg8::Unit&) const { return false; }
    __device__ __forceinline__ void epilogue(pg8::Acc& acc, const pg8::Unit& u, int wr, int wc, int fr, int fq) const {
        const int row0 = u.pm * 256 + wr * 64 + fr, col0 = u.pn * 256 + wc * 32 + 8 * fq;
#pragma unroll
        for (int ai = 0; ai < 2; ++ai)
#pragma unroll
            for (int m = 0; m < 4; ++m) { const int r = row0 + ai * 128 + m * 16; const int dst = row_dst[r]; const float w_ = row_w[r];
                if (dst >= 0) { bf16_t* rowp = Yexp + (size_t)dst * 1024 + col0;
#pragma unroll
                    for (int bj = 0; bj < 2; ++bj) { const f32x4 v0 = acc[ai][bj][m][0] * w_, v1 = acc[ai][bj][m][1] * w_;
                        u32x4 w; w.x = cvt_pk_bf16(v0[0], v0[1]); w.y = cvt_pk_bf16(v0[2], v0[3]); w.z = cvt_pk_bf16(v1[0], v1[1]); w.w = cvt_pk_bf16(v1[2], v1[3]);
                        *(u32x4*)(rowp + bj * 128) = w; } } }
    }
};

constexpr int NPH = 11;
__global__ void __launch_bounds__(NWAVES * 64, 2) mk_fwd(Args args_unused) {
    extern __shared__ __attribute__((aligned(16))) unsigned char lds_raw[];
    typedef const Args __attribute__((address_space(4))) CArgs;
#define ARG(f) ([&]() { CArgs* p_ = (CArgs*)__builtin_amdgcn_kernarg_segment_ptr(); asm volatile("" : "+s"(p_)); return p_->f; }())
    Frame F;
    F.lds = (LAS unsigned char*)lds_raw;
    F.tid = threadIdx.x; F.lane = F.tid & 63; F.wave = __builtin_amdgcn_readfirstlane(F.tid >> 6);
    F.G = gridDim.x; { const int bx = blockIdx.x; F.vcu = (F.G % 8 == 0) ? (bx % 8) * (F.G / 8) + bx / 8 : bx; }
    unsigned char* ws = ARG(ws); F.ws = ws; F.ctl = (gu32*)(ws + WS_CTL);
    volatile LAS unsigned* MISC = (volatile LAS unsigned*)(F.lds + MISC_OFF);
    for (int u = F.tid; u < (LDS_BYTES - MISC_OFF) / 4; u += NWAVES * 64) ((LAS unsigned*)(F.lds + MISC_OFF))[u] = 0u;
    __syncthreads();
    XcdBarrier bar; bar.bar = (unsigned*)(F.ctl + CW_BAR); bar.x = 0; bar.st = nullptr;
    if (MK_N_LAUNCHES == 1) bar = xcd_barrier_post((unsigned*)(F.ctl + CW_BAR), MISC + 8);
    const int lo = ARG(ph_lo), hi = ARG(ph_hi);
#if defined(DBG_STAGE)
    if (lo > DBG_STAGE + 1) return;
#endif
#ifndef PH_MASK
#define PH_MASK 0xFFFF
#endif
#define IN(k) (((PH_MASK >> (k)) & 1) && lo <= (k) && (k) < hi)
#ifndef REPEAT_PH
#define REPEAT_PH (-1)
#endif
#define REP(k) for (int rep_ = 0; rep_ < ((REPEAT_PH == (k)) ? 2 : 1); ++rep_)
#if defined(DBG_TA)
    unsigned long long tA0 = 0, tA1 = 0, tB0 = 0, tB1 = 0;
#define STAMP(k) do { if ((k) == DBG_TA) tA0 = __builtin_amdgcn_s_memrealtime(); if ((k) == DBG_TA + 1) tA1 = __builtin_amdgcn_s_memrealtime(); \
                      if ((k) == DBG_TB) tB0 = __builtin_amdgcn_s_memrealtime(); if ((k) == DBG_TB + 1) tB1 = __builtin_amdgcn_s_memrealtime(); } while (0)
#else
#define STAMP(k) do {} while (0)
#endif
#define SEAM(k) do { if (IN(k) && IN((k) + 1)) xcd_barrier(bar); } while (0)
    const int gw = F.vcu * NWAVES + F.wave, NGW = F.G * NWAVES;
    bf16_t* Win_t = (bf16_t*)(ws + WS_WIN); bf16_t* Wpa_t = (bf16_t*)(ws + WS_WPA); bf16_t* Wpb_t = (bf16_t*)(ws + WS_WPB); bf16_t* Wo_t = (bf16_t*)(ws + WS_WO);
    bf16_t* XN = (bf16_t*)(ws + WS_C); bf16_t* OA = (bf16_t*)(ws + WS_OA); bf16_t* OB = (bf16_t*)(ws + WS_OB); bf16_t* H2 = (bf16_t*)(ws + WS_C);
    bf16_t* QKV = (bf16_t*)(ws + WS_D); bf16_t* Wup = (bf16_t*)(ws + WS_UP); bf16_t* Wdn = (bf16_t*)(ws + WS_DN); bf16_t* YEXP = (bf16_t*)(ws + WS_YEXP);
    bf16_t* Y = (bf16_t*)(ws + WS_Y); float* X1 = (float*)(ws + WS_X1); bf16_t* GATES = (bf16_t*)ARG(out); bf16_t* HB = (bf16_t*)ARG(out);
    unsigned char* misc = ws + WS_MISC;
    float* LF = (float*)(misc + MS_LF); float* FB = (float*)(misc + MS_FB); u32x2* UNITS = (u32x2*)(misc + MS_UNITS);
    int* ASG_E = (int*)(misc + MS_ASG); float* ASG_W = (float*)(misc + MS_ASG + (size_t)M * 8); int* ASG_R = (int*)(misc + MS_ASG + (size_t)M * 16);
    int* HIST = (int*)(misc + MS_HIST); int* ROW_TOK = (int*)(misc + MS_ROWTOK); int* ROW_DST = (int*)(misc + MS_ROWDST); float* ROW_W = (float*)(misc + MS_ROWW); int* TILE_E = (int*)(misc + MS_TILEE);

    STAMP(0);
    if (IN(0)) REP(0) { if (rep_) xcd_barrier(bar);
        LAS float* scr = (LAS float*)(F.lds + RING_OFF + F.wave * 8704);
        if ((int)blockIdx.x == F.G - 1) {
            LAS int* cnt = (LAS int*)(F.lds + 98304);
            if (F.tid < 64) cnt[F.tid] = 0;
            __syncthreads();
            for (int i = F.tid; i < att::NUNITS; i += 512) { unsigned d, s; int c; att::decode_unit(i, d, s, c); __hip_atomic_fetch_add(&cnt[40 - c], 1, __ATOMIC_RELAXED, __HIP_MEMORY_SCOPE_WORKGROUP); }
            __syncthreads();
            if (F.tid == 0) { int run = 0; for (int k = 0; k < 64; ++k) { const int c = cnt[k]; cnt[k] = run; run += c; } }
            __syncthreads();
            for (int i = F.tid; i < att::NUNITS; i += 512) { unsigned d, s; int c; att::decode_unit(i, d, s, c); const int pos = __hip_atomic_fetch_add(&cnt[40 - c], 1, __ATOMIC_RELAXED, __HIP_MEMORY_SCOPE_WORKGROUP); UNITS[pos] = (u32x2){d, s}; }
            __syncthreads();
        }
        { bf16_t* WRH = (bf16_t*)(misc + MS_WR); bf16_t* WRL = WRH + 48 * 1024; const float* wg = ARG(w_group); const float* we = ARG(w_expert);
          for (int i = (int)blockIdx.x * 512 + F.tid; i < 48 * 1024; i += F.G * 512) { const int c = i >> 10, k = i & 1023;
              const float v = (c < 4) ? wg[k * 4 + c] : (c < 36) ? we[k * 32 + (c - 4)] : 0.f; const unsigned h_ = f2bf(v);
              WRH[i] = (bf16_t)h_; WRL[i] = (bf16_t)f2bf(v - __builtin_bit_cast(float, h_ << 16)); } }
        {
            constexpr int I_IN = 16 * 160, I_PA = 8 * 32, I_WO = 16 * 32, NIT = I_IN + 2 * I_PA + I_WO;
            for (int it = gw; it < NIT; it += NGW) {
                int r = it;
                if (r < I_IN) { const int kb = r / 160, nb = r % 160, n0 = 32 * nb, sc = n0 + (n0 >= 1536 ? 8 : 0); transpose_item(ARG(w_in) + (size_t)(64 * kb) * 5128 + sc, 5128, Win_t + (size_t)n0 * 1024 + 64 * kb, 1024, scr, F.lane); continue; } r -= I_IN;
                if (r < I_PA) { const int kb = r / 32, nb = r % 32; transpose_item(ARG(w_pa) + (size_t)(64 * kb) * 1024 + 32 * nb, 1024, Wpa_t + (size_t)(32 * nb) * 512 + 64 * kb, 512, scr, F.lane); continue; } r -= I_PA;
                if (r < I_PA) { const int kb = r / 32, nb = r % 32; transpose_item(ARG(w_pb) + (size_t)(64 * kb) * 1024 + 32 * nb, 1024, Wpb_t + (size_t)(32 * nb) * 512 + 64 * kb, 512, scr, F.lane); continue; } r -= I_PA;
                { const int kb = r / 32, nb = r % 32; transpose_item(ARG(w_o) + (size_t)(64 * kb) * 1024 + 32 * nb, 1024, Wo_t + (size_t)(32 * nb) * 1024 + 64 * kb, 1024, scr, F.lane); }
            }
        }
        {
            LAS float* wf = (LAS float*)(F.lds + 73728);
            __syncthreads();
            for (int i = F.tid; i < 8192; i += 512) { const int k = i >> 3, c = i & 7; wf[c * 1024 + k] = ARG(w_in)[(size_t)k * 5128 + 1536 + c]; }
            __syncthreads();
            for (int m = gw; m < M; m += NGW) {
                const GAS f32x4* xr = (const GAS f32x4*)(ARG(x) + (size_t)m * DM) + F.lane;
                f32x4 v[4]; float s = 0.f;
#pragma unroll
                for (int j = 0; j < 4; ++j) { v[j] = xr[64 * j]; s += (v[j].x * v[j].x + v[j].y * v[j].y) + (v[j].z * v[j].z + v[j].w * v[j].w); }
                const float rstd = 1.0f / sqrtf(wave_sum(s) * (1.f / DM) + EPS);
                float fa[8];
#pragma unroll
                for (int c = 0; c < 8; ++c) fa[c] = 0.f;
                GAS unsigned long long* o8 = (GAS unsigned long long*)(XN + (size_t)m * DM) + F.lane;
#pragma unroll
                for (int j = 0; j < 4; ++j) { const f32x4 g = *((const GAS f32x4*)ARG(g_mix) + 64 * j + F.lane); const f32x4 hv = v[j] * rstd * g;
                    o8[64 * j] = (unsigned long long)pk2(hv.x, hv.y) | ((unsigned long long)pk2(hv.z, hv.w) << 32);
#pragma unroll
                    for (int c = 0; c < 8; ++c) { const f32x4 w = *(const LAS f32x4*)(wf + c * 1024 + 4 * (64 * j + F.lane)); fa[c] += (hv.x * w.x + hv.y * w.y) + (hv.z * w.z + hv.w * w.w); } }
#pragma unroll
                for (int c = 0; c < 8; ++c) fa[c] = wave_sum(fa[c]);
                if (F.lane < 8) { float z = 0.f;
#pragma unroll
                    for (int c = 0; c < 8; ++c) z = (F.lane == c) ? fa[c] : z;
                    z += ARG(b_fgate)[F.lane];
                    const float ls = (z >= 0.f) ? -log1pf(expf(-z)) : (z - log1pf(expf(z)));
                    const int bb = m >> 13, sidx = m & (SEQ - 1);
                    LF[(size_t)(bb * 8 + F.lane) * SEQ + sidx] = ls; }
            }
        }
    }
    SEAM(0);

    STAMP(1);
    if (IN(1)) REP(1) { if (rep_) xcd_barrier(bar);
        if ((int)blockIdx.x < 16) {
            const float* lf = LF + (size_t)blockIdx.x * SEQ; float* fb = FB + (size_t)blockIdx.x * SEQ;
            LAS float* wt = (LAS float*)(F.lds + RING_OFF);
            float v[16]; float run = 0.f;
#pragma unroll
            for (int i = 0; i < 4; ++i) { const f32x4 a = *(const f32x4*)(lf + F.tid * 16 + 4 * i); v[4 * i] = a.x; v[4 * i + 1] = a.y; v[4 * i + 2] = a.z; v[4 * i + 3] = a.w; }
#pragma unroll
            for (int i = 0; i < 16; ++i) { run += v[i]; v[i] = run; }
            float incl = run;
#pragma unroll
            for (int off = 1; off < 64; off <<= 1) { const float n = __shfl_up(incl, off); if (F.lane >= off) incl += n; }
            if (F.lane == 63) wt[F.wave] = incl;
            __syncthreads();
            float base = incl - run;
            for (int w = 0; w < F.wave; ++w) base += wt[w];
#pragma unroll
            for (int i = 0; i < 4; ++i) { f32x4 a; a.x = -(v[4 * i] + base) * LOG2E; a.y = -(v[4 * i + 1] + base) * LOG2E; a.z = -(v[4 * i + 2] + base) * LOG2E; a.w = -(v[4 * i + 3] + base) * LOG2E; *(f32x4*)(fb + F.tid * 16 + 4 * i) = a; }
            __syncthreads();
        }
        PolInProj P; P.K = DM; P.A = XN; P.Bt = Win_t; P.so.init(M, NPROJ, F.G, (int)blockIdx.x); P.qkv = QKV; P.gates = GATES; P.b_gate = ARG(b_gate); P.kmax = (unsigned*)(F.ctl + CW_KMAX);
        pg8::gemm_run(F.lds + RING_OFF, P);
    }
    SEAM(1);

#if defined(DBG_STAGE)
#define DBG_DUMP(stage, EXPR) if (DBG_STAGE == (stage) && IN((stage) + 1)) { __syncthreads(); \
        for (int m = gw; m < M; m += NGW) { for (int q = 0; q < 16; ++q) { const int c = q * 64 + F.lane; ARG(out)[(size_t)m * DM + c] = (EXPR); } } return; }
#else
#define DBG_DUMP(stage, EXPR)
#endif
#define BF(p) bf_lo((unsigned)(p))
    DBG_DUMP(1, BF(QKV[(size_t)m * 512 + (c & 511)]) * (c < 512 ? 1.f : 0.f) + BF(QKV[(QKV_STRIDE / 2) + (size_t)m * 512 + (c & 511)]) * (c < 512 ? 0.f : 1.f)
        + 3.f * BF(QKV[2 * (QKV_STRIDE / 2) + (size_t)m * 512 + (c & 511)]) * (c < 512 ? 1.f : 0.f) + 3.f * BF(QKV[3 * (QKV_STRIDE / 2) + (size_t)m * 512 + (c & 511)]) * (c < 512 ? 0.f : 1.f)
        + 5.f * BF(QKV[4 * (QKV_STRIDE / 2) + (size_t)m * 512 + (c & 511)]) * (c < 512 ? 1.f : 0.f) + 5.f * BF(QKV[5 * (QKV_STRIDE / 2) + (size_t)m * 512 + (c & 511)]) * (c < 512 ? 0.f : 1.f) + 0.001f * FB[(size_t)((m >> 13) * 8 + (c & 7)) * SEQ + (m & 8191)])
#if defined(DBG_CHECK) && (DBG_CHECK == 3 || DBG_CHECK == 4)
#define DBG_CHK_PH 2
    if (IN(DBG_CHK_PH)) {
        unsigned* dmax = (unsigned*)(F.ctl + 300);
        float md = 0.f;
        const int rows14[14] = {0, 31, 32, 63, 64, 100, 255, 256, 511, 1000, 2047, 4096, 5000, 8191};
        if (DBG_CHECK == 1) {
            for (int task = gw; task < 16 * 14; task += NGW) {
                const int bh = task / 14, b = bh >> 3, h = bh & 7; int i = 0;
                for (int q = 0; q < 14; ++q) if (q == task % 14) i = rows14[q];
                const bf16_t* Q = QKV + ((size_t)b * SEQ + i) * 512 + h * 64; const bf16_t* Kp = QKV + QKV_STRIDE / 2 + (size_t)b * SEQ * 512 + h * 64; const bf16_t* Vp = QKV + 2 * (QKV_STRIDE / 2) + (size_t)b * SEQ * 512 + h * 64;
                const float* fb = FB + (size_t)bh * SEQ;
                const float qd = BF(Q[F.lane]); float m = -1e30f, l = 0.f, acc = 0.f;
                for (int j = i; j >= 0; --j) { const float sc = wave_sum(qd * BF(Kp[(size_t)j * 512 + F.lane])) + fb[j];
                    const float mn = fmaxf(m, sc), f = __builtin_amdgcn_exp2f(m - mn), p = __builtin_amdgcn_exp2f(sc - mn); l = l * f + p; acc = acc * f + p * BF(Vp[(size_t)j * 512 + F.lane]); m = mn; }
                const float ref = acc / l, got = BF(OA[((size_t)b * SEQ + i) * 512 + h * 64 + F.lane]);
                md = fmaxf(md, fabsf(ref - got));
            }
        } else if (DBG_CHECK == 2) {
            const float lam = expf(wave_sum(ARG(lq1)[F.lane] * ARG(lk1)[F.lane])) - expf(wave_sum(ARG(lq2)[F.lane] * ARG(lk2)[F.lane])) + LAM_INIT;
            for (int task = gw; task < 8 * 14; task += NGW) {
                const int bh = task / 14, b = bh >> 2, h = bh & 3; int i = 0;
                for (int q = 0; q < 14; ++q) if (q == task % 14) i = rows14[q];
                const float sl2 = LOG2E * __builtin_amdgcn_exp2f(-2.0f * (float)(h + 1));
                const bf16_t* Q = QKV + 3 * (QKV_STRIDE / 2) + ((size_t)b * SEQ + i) * 512 + h * 128; const bf16_t* Kp = QKV + 4 * (QKV_STRIDE / 2) + (size_t)b * SEQ * 512 + h * 128; const bf16_t* Vp = QKV + 5 * (QKV_STRIDE / 2) + (size_t)b * SEQ * 512 + h * 128;
                const float q1 = BF(Q[F.lane]), q2 = BF(Q[64 + F.lane]); float m1 = -1e30f, l1 = 0.f, a1 = 0.f, c1 = 0.f, m2 = -1e30f, l2 = 0.f, a2 = 0.f, c2 = 0.f;
                const int jmax = (i | 63);
                const int jlo_ = ((jmax >> 6) - (DBG_NTILES - 1)) > 0 ? ((jmax >> 6) - (DBG_NTILES - 1)) * 64 : 0;
                for (int j = jmax; j >= jlo_; --j) { const float bias = -sl2 * fabsf((float)(i - j));
                    const float s1 = wave_sum(q1 * BF(Kp[(size_t)j * 512 + F.lane])) + bias, s2 = wave_sum(q2 * BF(Kp[(size_t)j * 512 + 64 + F.lane])) + bias;
                    const float va = BF(Vp[(size_t)j * 512 + F.lane]), vb = BF(Vp[(size_t)j * 512 + 64 + F.lane]);
                    { const float mn = fmaxf(m1, s1), f = __builtin_amdgcn_exp2f(m1 - mn), p = __builtin_amdgcn_exp2f(s1 - mn); l1 = l1 * f + p; a1 = a1 * f + p * va; c1 = c1 * f + p * vb; m1 = mn; }
                    { const float mn = fmaxf(m2, s2), f = __builtin_amdgcn_exp2f(m2 - mn), p = __builtin_amdgcn_exp2f(s2 - mn); l2 = l2 * f + p; a2 = a2 * f + p * va; c2 = c2 * f + p * vb; m2 = mn; } }
                const float oa_ = a1 / l1 - lam * a2 / l2, ob_ = c1 / l1 - lam * c2 / l2;
                const float rstd = 0.8f / sqrtf(wave_sum(oa_ * oa_ + ob_ * ob_) * (1.f / 128.f) + EPS);
                const float r0 = oa_ * rstd * ARG(g_subln)[F.lane], r1 = ob_ * rstd * ARG(g_subln)[64 + F.lane];
                const float g0 = BF(OB[((size_t)b * SEQ + i) * 512 + h * 128 + F.lane]), g1 = BF(OB[((size_t)b * SEQ + i) * 512 + h * 128 + 64 + F.lane]);
                if (((DBG_SELH >> h) & 1) && ((DBG_SELR >> (task % 14)) & 1)) md = fmaxf(md, fmaxf(fabsf(r0 - g0), fabsf(r1 - g1)));
            }
        } else if (DBG_CHECK == 5) {
            const float* xp = ARG(x); const float* gm = ARG(g_mix);
            for (int task = gw; task < 8 * 14; task += NGW) {
                const int bh = task / 14, b = bh >> 2, h = bh & 3; int i = 0;
                for (int q = 0; q < 14; ++q) if (q == task % 14) i = rows14[q];
                if (!(((DBG_SELH >> h) & 1) && ((DBG_SELR >> (task % 14)) & 1))) continue;
                const size_t e = ((size_t)b * SEQ + i) * 512 + h * 128 + F.lane; const int m = 8192 + (int)(e >> 10), c = (int)(e & 1023);
                float ss = 0.f; for (int k = F.lane; k < 1024; k += 64) { const float v = xp[(size_t)m * 1024 + k]; ss += v * v; }
                const float rstd = 1.0f / sqrtf(wave_sum(ss) * (1.f / DM) + EPS);
                const float xn = BF((bf16_t)f2bf(xp[(size_t)m * 1024 + c] * rstd * gm[c]));
                md = fmaxf(md, fabsf(xn - BF(OB[e])));
            }
        } else if (DBG_CHECK == 3) {
            for (int task = gw; task < 4096; task += NGW) {
                const int mrow = (task * 2654435 + 977) & (M - 1);
                for (int q = 0; q < 4; ++q) { const int n = (task * 131 + q * 1283 + F.lane * 79 + 17) % 5120;
                    float d = 0.f; for (int k = 0; k < 1024; ++k) d += BF(XN[(size_t)mrow * 1024 + k]) * BF(Win_t[(size_t)n * 1024 + k]);
                    float got, ref;
                    if (n < 3072) { const int t6 = n / 512; got = BF(QKV[(size_t)t6 * (QKV_STRIDE / 2) + (size_t)mrow * 512 + (n % 512)]); ref = d * ((t6 == 0 || t6 == 3) ? C2 : 1.f); }
                    else { const int g = (n - 3072) / 1024, gc = (n - 3072) % 1024; got = BF(GATES[(size_t)g * M * 1024 + (size_t)mrow * 1024 + gc]); ref = 1.f / (1.f + expf(-(d + ARG(b_gate)[g * 1024 + gc]))); }
                    const int cls = (n < 3072) ? (n / 512) : 6 + (n - 3072) / 1024;
                    if ((DBG_SELH >> cls) & 1) { if (fabsf(got - ref) > 0.05f) md += 1.0f; } }
            }
        } else if (DBG_CHECK == 4) {
            for (int task = gw; task < 8192; task += NGW) {
                const int n = (task * 37 + F.lane * 83) % 5120, k = (task * 91 + F.lane * 7) & 1023; const int scol = n + (n >= 1536 ? 8 : 0);
                md = fmaxf(md, fabsf(BF(Win_t[(size_t)n * 1024 + k]) - BF((bf16_t)f2bf(ARG(w_in)[(size_t)k * 5128 + scol]))));
                const int n2 = (task * 53 + F.lane * 29) & 1023, k2 = (task * 17 + F.lane * 3) & 511;
                md = fmaxf(md, fabsf(BF(Wpa_t[(size_t)n2 * 512 + k2]) - BF((bf16_t)f2bf(ARG(w_pa)[(size_t)k2 * 1024 + n2]))));
                md = fmaxf(md, fabsf(BF(Wpb_t[(size_t)n2 * 512 + k2]) - BF((bf16_t)f2bf(ARG(w_pb)[(size_t)k2 * 1024 + n2]))));
                md = fmaxf(md, fabsf(BF(Wo_t[(size_t)n2 * 1024 + k]) - BF((bf16_t)f2bf(ARG(w_o)[(size_t)k * 1024 + n2]))));
            }
        }
#if DBG_CHECK == 3
        md = wave_sum(md);
        if (F.lane == 0) atomicAdd((unsigned*)(F.ctl + 301), (unsigned)md);
        if (F.lane == 0) atomicMax(dmax, 0u);
#else
        md = wave_max(md);
        if (F.lane == 0) atomicMax(dmax, __float_as_uint(md));
#endif
        return;
    }
    if (IN(DBG_CHK_PH + 1)) { float d = __uint_as_float(__hip_atomic_load((unsigned*)(F.ctl + 300), RLX_AGENT)); if (DBG_CHECK == 3) d = 1e-3f * (float)__hip_atomic_load((unsigned*)(F.ctl + 301), RLX_AGENT); float* outp = ARG(out);
        for (int m = gw; m < M; m += NGW) for (int q = 0; q < 16; ++q) outp[(size_t)m * DM + q * 64 + F.lane] = (m == 0 && q == 0 && F.lane == 0) ? 1e4f * d : 0.f;
        return; }
    if (lo > DBG_CHK_PH + 1) return;
#endif
    STAMP(2);
    if (IN(2)) REP(2) { if (rep_) xcd_barrier(bar);
        att::Tensors T; T.ws = ws; T.g_subln = ARG(g_subln);
        { const float a1 = wave_sum(ARG(lq1)[F.lane] * ARG(lk1)[F.lane]), a2 = wave_sum(ARG(lq2)[F.lane] * ARG(lk2)[F.lane]); T.lam = expf(a1) - expf(a2) + LAM_INIT; }
        LAS unsigned* qw = (LAS unsigned*)(F.lds + L_AUX + 128);
        for (;;) {
            if (F.tid == 0) qw[0] = __hip_atomic_fetch_add((unsigned*)(F.ctl + CW_QHEAD + 16 * rep_), 1u, RLX_AGENT);
            __syncthreads();
            const unsigned id = qw[0];
            __syncthreads();
            if (id >= (unsigned)att::NUNITS) break;
            const u32x2 ud = UNITS[id];
            const unsigned d = (unsigned)__builtin_amdgcn_readfirstlane(ud.x); const int slot0 = __builtin_amdgcn_readfirstlane(ud.y);
            const int b = (d >> 1) & 1, h = (d >> 2) & 7, qb = (d >> 5) & 63, seg = (d >> 11) & 7, nseg = (d >> 14) & 7;
#ifndef NO_FOX
            if ((d & 1u) == 0u) att::attn_unit<false>(T, b, h, qb, 0, 4 * qb + 3, false, 0, (LAS char*)F.lds);
            else
#endif
#ifndef NO_DIFF
            {
#if defined(DBG_NOSPLIT)
                if (seg == 0) att::attn_unit<true>(T, b, h, qb, (2 * qb + 1 - (DBG_NTILES - 1)) > 0 ? (2 * qb + 1 - (DBG_NTILES - 1)) : 0, 2 * qb + 1, false, 0, (LAS char*)F.lds);
#else
                const int t_hi = 2 * qb + 1 - seg * SEG, t_lo = (seg == nseg - 1) ? 0 : t_hi - SEG + 1;
                att::attn_unit<true>(T, b, h, qb, t_lo, t_hi, nseg > 1, slot0 + seg, (LAS char*)F.lds);
#endif
            }
#else
            {}
#endif
        }
    }
    SEAM(2);

    DBG_DUMP(2, (c < 512 ? BF(OA[(size_t)m * 512 + c]) : ((((m & 8191) >> 7) < 16 || (((c - 512) >> 7) < 2)) ? BF(OB[(size_t)m * 512 + c - 512]) : 0.f)))
    STAMP(3);
    if (IN(3)) REP(3) { if (rep_) xcd_barrier(bar);
        REP(31) {
            att::Tensors T; T.ws = ws; T.g_subln = ARG(g_subln);
            { const float a1 = wave_sum(ARG(lq1)[F.lane] * ARG(lk1)[F.lane]), a2 = wave_sum(ARG(lq2)[F.lane] * ARG(lk2)[F.lane]); T.lam = expf(a1) - expf(a2) + LAM_INIT; }
            const int wid = F.wave, lane = F.lane, r32 = lane & 31, hi = lane >> 5;
#if defined(DBG_NOSPLIT)
            for (int gi = 192; gi < 192; gi += F.G) {
#else
            for (int gi = F.vcu; gi < 192; gi += F.G) {
#endif
                const int h = 2 + (gi / 96), rr = gi % 96, b = rr / 48, qb = 16 + rr % 48;
                const int nseg = (h == 2) ? 2 : (qb >> 4) + 1;
                const int slot0 = (h == 2) ? (b * 48 + (qb - 16)) * 2 : 192 + b * 144 + (qb < 32 ? 2 * (qb - 16) : qb < 48 ? 32 + 3 * (qb - 32) : 80 + 4 * (qb - 48));
                LAS float* sc = (LAS float*)(F.lds + L_WSF) + wid * 256;
                for (int s = 0; s < nseg; ++s) { const f32x2 ml = *((const f32x2*)(T.part() + (size_t)(slot0 + s) * PART_SLOT + 8 * 64 * 64 * 4) + wid * 32 + r32);
                    if (hi == 0) { sc[(s * 32 + r32) * 2] = ml.x; sc[(s * 32 + r32) * 2 + 1] = ml.y; } }
                LDS_WAIT();
                f32x16 o[4]; float inv[16], mst[16];
#pragma unroll
                for (int g = 0; g < 4; ++g) o[g] = f32x16{};
#pragma unroll
                for (int r = 0; r < 16; ++r) { float mm = sc[(att::crow(r, hi)) * 2]; for (int s = 1; s < nseg; ++s) mm = fmaxf(mm, sc[(s * 32 + att::crow(r, hi)) * 2]); mst[r] = mm; inv[r] = 0.f; }
                for (int s = 0; s < nseg; ++s) {
                    const float* po = (const float*)(T.part() + (size_t)(slot0 + s) * PART_SLOT) + (size_t)wid * 4096;
                    float fs[16];
#pragma unroll
                    for (int r = 0; r < 16; ++r) { const int row = att::crow(r, hi); fs[r] = __builtin_amdgcn_exp2f(sc[(s * 32 + row) * 2] - mst[r]); inv[r] += fs[r] * sc[(s * 32 + row) * 2 + 1]; }
#pragma unroll
                    for (int g = 0; g < 4; ++g) {
#pragma unroll
                        for (int r = 0; r < 16; ++r) o[g][r] += fs[r] * po[(g * 16 + r) * 64 + lane];
                        asm volatile("" ::: "memory"); }
                }
#pragma unroll
                for (int r = 0; r < 16; ++r) inv[r] = __builtin_amdgcn_rcpf(inv[r]);
                att::diff_finish(o, inv, wid, lane, (LAS char*)F.lds + RING_OFF, T, b, h, qb * 128);
                __syncthreads();
            }
        }
        REP(32) {
            LAS float* scr = (LAS float*)(F.lds + 65536 + F.wave * 8704);
            __syncthreads();
            constexpr int I_UP = 16 * 16, I_DN = 8 * 32, PER_E = 2 * I_UP + I_DN;
            const float* w1p = ARG(w1); const float* w3p = ARG(w3); const float* w2p = ARG(w2);
            auto item_ptrs = [&](int it, const float*& src, int& ldn, bf16_t*& dst, int& ldk) {
                const int e = it / PER_E; int r = it % PER_E;
                if (r < 2 * I_UP) { const int sel = r / I_UP; r %= I_UP; const int kb = r / 16, nb = r % 16, n0 = 32 * nb;
                    src = (sel ? w3p : w1p) + ((size_t)e * 1024 + 64 * kb) * 512 + n0; ldn = 512;
                    const int nd = (n0 >> 7) * 256 + sel * 128 + (n0 & 127);
                    dst = Wup + ((size_t)e * 1024 + nd) * 1024 + 64 * kb; ldk = 1024;
                } else { r -= 2 * I_UP; const int kb = r / 32, nb = r % 32;
                    src = w2p + ((size_t)e * 512 + 64 * kb) * 1024 + 32 * nb; ldn = 1024; dst = Wdn + ((size_t)e * 1024 + 32 * nb) * 512 + 64 * kb; ldk = 512; }
            };
#if defined(DBG_CHECK)
            const int it_end = 0;
#else
            const int it_end = NEXP * PER_E;
#endif
            TrRegs Ra, Rb; const float* src; int ldn; bf16_t* dst; int ldk; bf16_t* dst2; int ldk2;
            for (int ch = F.vcu; ch * 16 < it_end; ch += F.G) {
                const int ia = ch * 16 + F.wave * 2;
                item_ptrs(ia, src, ldn, dst, ldk); tr_load(Ra, src, ldn, F.lane);
                item_ptrs(ia + 1, src, ldn, dst2, ldk2); tr_load(Rb, src, ldn, F.lane);
                tr_store(Ra, dst, ldk, scr, F.lane);
                tr_store(Rb, dst2, ldk2, scr, F.lane);
            }
        }
    }
    SEAM(3);

    DBG_DUMP(3, (c < 512 ? BF(OA[(size_t)m * 512 + c]) : BF(OB[(size_t)m * 512 + c - 512])))
#if defined(DBG_CHECK) && !(DBG_CHECK == 3 || DBG_CHECK == 4)
#define DBG_CHK_PH 4
    if (IN(DBG_CHK_PH)) {
        unsigned* dmax = (unsigned*)(F.ctl + 300);
        float md = 0.f;
        const int rows14[14] = {0, 31, 32, 63, 64, 100, 255, 256, 511, 1000, 2047, 4096, 5000, 8191};
        if (DBG_CHECK == 1) {
            for (int task = gw; task < 16 * 14; task += NGW) {
                const int bh = task / 14, b = bh >> 3, h = bh & 7; int i = 0;
                for (int q = 0; q < 14; ++q) if (q == task % 14) i = rows14[q];
                const bf16_t* Q = QKV + ((size_t)b * SEQ + i) * 512 + h * 64; const bf16_t* Kp = QKV + QKV_STRIDE / 2 + (size_t)b * SEQ * 512 + h * 64; const bf16_t* Vp = QKV + 2 * (QKV_STRIDE / 2) + (size_t)b * SEQ * 512 + h * 64;
                const float* fb = FB + (size_t)bh * SEQ;
                const float qd = BF(Q[F.lane]); float m = -1e30f, l = 0.f, acc = 0.f;
                for (int j = i; j >= 0; --j) { const float sc = wave_sum(qd * BF(Kp[(size_t)j * 512 + F.lane])) + fb[j];
                    const float mn = fmaxf(m, sc), f = __builtin_amdgcn_exp2f(m - mn), p = __builtin_amdgcn_exp2f(sc - mn); l = l * f + p; acc = acc * f + p * BF(Vp[(size_t)j * 512 + F.lane]); m = mn; }
                const float ref = acc / l, got = BF(OA[((size_t)b * SEQ + i) * 512 + h * 64 + F.lane]);
                md = fmaxf(md, fabsf(ref - got));
            }
        } else if (DBG_CHECK == 2) {
            const float lam = expf(wave_sum(ARG(lq1)[F.lane] * ARG(lk1)[F.lane])) - expf(wave_sum(ARG(lq2)[F.lane] * ARG(lk2)[F.lane])) + LAM_INIT;
            for (int task = gw; task < 8 * 14; task += NGW) {
                const int bh = task / 14, b = bh >> 2, h = bh & 3; int i = 0;
                for (int q = 0; q < 14; ++q) if (q == task % 14) i = rows14[q];
                const float sl2 = LOG2E * __builtin_amdgcn_exp2f(-2.0f * (float)(h + 1));
                const bf16_t* Q = QKV + 3 * (QKV_STRIDE / 2) + ((size_t)b * SEQ + i) * 512 + h * 128; const bf16_t* Kp = QKV + 4 * (QKV_STRIDE / 2) + (size_t)b * SEQ * 512 + h * 128; const bf16_t* Vp = QKV + 5 * (QKV_STRIDE / 2) + (size_t)b * SEQ * 512 + h * 128;
                const float q1 = BF(Q[F.lane]), q2 = BF(Q[64 + F.lane]); float m1 = -1e30f, l1 = 0.f, a1 = 0.f, c1 = 0.f, m2 = -1e30f, l2 = 0.f, a2 = 0.f, c2 = 0.f;
                const int jmax = (i | 63);
                const int jlo_ = ((jmax >> 6) - (DBG_NTILES - 1)) > 0 ? ((jmax >> 6) - (DBG_NTILES - 1)) * 64 : 0;
                for (int j = jmax; j >= jlo_; --j) { const float bias = -sl2 * fabsf((float)(i - j));
                    const float s1 = wave_sum(q1 * BF(Kp[(size_t)j * 512 + F.lane])) + bias, s2 = wave_sum(q2 * BF(Kp[(size_t)j * 512 + 64 + F.lane])) + bias;
                    const float va = BF(Vp[(size_t)j * 512 + F.lane]), vb = BF(Vp[(size_t)j * 512 + 64 + F.lane]);
                    { const float mn = fmaxf(m1, s1), f = __builtin_amdgcn_exp2f(m1 - mn), p = __builtin_amdgcn_exp2f(s1 - mn); l1 = l1 * f + p; a1 = a1 * f + p * va; c1 = c1 * f + p * vb; m1 = mn; }
                    { const float mn = fmaxf(m2, s2), f = __builtin_amdgcn_exp2f(m2 - mn), p = __builtin_amdgcn_exp2f(s2 - mn); l2 = l2 * f + p; a2 = a2 * f + p * va; c2 = c2 * f + p * vb; m2 = mn; } }
                const float oa_ = a1 / l1 - lam * a2 / l2, ob_ = c1 / l1 - lam * c2 / l2;
                const float rstd = 0.8f / sqrtf(wave_sum(oa_ * oa_ + ob_ * ob_) * (1.f / 128.f) + EPS);
                const float r0 = oa_ * rstd * ARG(g_subln)[F.lane], r1 = ob_ * rstd * ARG(g_subln)[64 + F.lane];
                const float g0 = BF(OB[((size_t)b * SEQ + i) * 512 + h * 128 + F.lane]), g1 = BF(OB[((size_t)b * SEQ + i) * 512 + h * 128 + 64 + F.lane]);
                if (((DBG_SELH >> h) & 1) && ((DBG_SELR >> (task % 14)) & 1)) md = fmaxf(md, fmaxf(fabsf(r0 - g0), fabsf(r1 - g1)));
            }
        } else if (DBG_CHECK == 5) {
            const float* xp = ARG(x); const float* gm = ARG(g_mix);
            for (int task = gw; task < 8 * 14; task += NGW) {
                const int bh = task / 14, b = bh >> 2, h = bh & 3; int i = 0;
                for (int q = 0; q < 14; ++q) if (q == task % 14) i = rows14[q];
                if (!(((DBG_SELH >> h) & 1) && ((DBG_SELR >> (task % 14)) & 1))) continue;
                const size_t e = ((size_t)b * SEQ + i) * 512 + h * 128 + F.lane; const int m = 8192 + (int)(e >> 10), c = (int)(e & 1023);
                float ss = 0.f; for (int k = F.lane; k < 1024; k += 64) { const float v = xp[(size_t)m * 1024 + k]; ss += v * v; }
                const float rstd = 1.0f / sqrtf(wave_sum(ss) * (1.f / DM) + EPS);
                const float xn = BF((bf16_t)f2bf(xp[(size_t)m * 1024 + c] * rstd * gm[c]));
                md = fmaxf(md, fabsf(xn - BF(OB[e])));
            }
        } else if (DBG_CHECK == 3) {
            for (int task = gw; task < 4096; task += NGW) {
                const int mrow = (task * 2654435 + 977) & (M - 1);
                for (int q = 0; q < 4; ++q) { const int n = (task * 131 + q * 1283 + F.lane * 79 + 17) % 5120;
                    float d = 0.f; for (int k = 0; k < 1024; ++k) d += BF(XN[(size_t)mrow * 1024 + k]) * BF(Win_t[(size_t)n * 1024 + k]);
                    float got, ref;
                    if (n < 3072) { const int t6 = n / 512; got = BF(QKV[(size_t)t6 * (QKV_STRIDE / 2) + (size_t)mrow * 512 + (n % 512)]); ref = d * ((t6 == 0 || t6 == 3) ? C2 : 1.f); }
                    else { const int g = (n - 3072) / 1024, gc = (n - 3072) % 1024; got = BF(GATES[(size_t)g * M * 1024 + (size_t)mrow * 1024 + gc]); ref = 1.f / (1.f + expf(-(d + ARG(b_gate)[g * 1024 + gc]))); }
                    const int cls = (n < 3072) ? (n / 512) : 6 + (n - 3072) / 1024;
                    if ((DBG_SELH >> cls) & 1) { if (fabsf(got - ref) > 0.05f) md += 1.0f; } }
            }
        } else if (DBG_CHECK == 4) {
            for (int task = gw; task < 8192; task += NGW) {
                const int n = (task * 37 + F.lane * 83) % 5120, k = (task * 91 + F.lane * 7) & 1023; const int scol = n + (n >= 1536 ? 8 : 0);
                md = fmaxf(md, fabsf(BF(Win_t[(size_t)n * 1024 + k]) - BF((bf16_t)f2bf(ARG(w_in)[(size_t)k * 5128 + scol]))));
                const int n2 = (task * 53 + F.lane * 29) & 1023, k2 = (task * 17 + F.lane * 3) & 511;
                md = fmaxf(md, fabsf(BF(Wpa_t[(size_t)n2 * 512 + k2]) - BF((bf16_t)f2bf(ARG(w_pa)[(size_t)k2 * 1024 + n2]))));
                md = fmaxf(md, fabsf(BF(Wpb_t[(size_t)n2 * 512 + k2]) - BF((bf16_t)f2bf(ARG(w_pb)[(size_t)k2 * 1024 + n2]))));
                md = fmaxf(md, fabsf(BF(Wo_t[(size_t)n2 * 1024 + k]) - BF((bf16_t)f2bf(ARG(w_o)[(size_t)k * 1024 + n2]))));
            }
        }
#if DBG_CHECK == 3
        md = wave_sum(md);
        if (F.lane == 0) atomicAdd((unsigned*)(F.ctl + 301), (unsigned)md);
        if (F.lane == 0) atomicMax(dmax, 0u);
#else
        md = wave_max(md);
        if (F.lane == 0) atomicMax(dmax, __float_as_uint(md));
#endif
        return;
    }
    if (IN(DBG_CHK_PH + 1)) { float d = __uint_as_float(__hip_atomic_load((unsigned*)(F.ctl + 300), RLX_AGENT)); if (DBG_CHECK == 3) d = 1e-3f * (float)__hip_atomic_load((unsigned*)(F.ctl + 301), RLX_AGENT); float* outp = ARG(out);
        for (int m = gw; m < M; m += NGW) for (int q = 0; q < 16; ++q) outp[(size_t)m * DM + q * 64 + F.lane] = (m == 0 && q == 0 && F.lane == 0) ? 1e4f * d : 0.f;
        return; }
    if (lo > DBG_CHK_PH + 1) return;
#endif
    STAMP(4);
    if (IN(4)) REP(4) { if (rep_) xcd_barrier(bar);
        PolGate P; P.K = 512; P.OA = OA; P.OB = OB; P.Wpa = Wpa_t; P.Wpb = Wpb_t; P.gates = GATES; P.Y = Y; P.so.init(M, DM, F.G, (int)blockIdx.x);
        pg8::gemm_run(F.lds + RING_OFF, P);
    }
    SEAM(4);

    STAMP(5);
    if (IN(5)) REP(5) { if (rep_) xcd_barrier(bar);
        PolWo P; P.K = DM; P.A = Y; P.Bt = Wo_t; P.x = ARG(x); P.x1 = X1; P.so.init(M, DM, F.G, (int)blockIdx.x);
        pg8::gemm_run(F.lds + RING_OFF, P);
    }
    SEAM(5);

#if defined(DBG_STAGE)
    if (DBG_STAGE == 5 && IN(6)) {
        const float* gf = ARG(g_final); float* outp = ARG(out);
        for (int m = gw; m < M; m += NGW) { float v[16]; float ss = 0.f;
#pragma unroll
            for (int q = 0; q < 16; ++q) { v[q] = X1[(size_t)m * 1024 + q * 64 + F.lane]; ss += v[q] * v[q]; }
            const float rstd = 1.0f / sqrtf(wave_sum(ss) * (1.f / DM) + EPS);
#pragma unroll
            for (int q = 0; q < 16; ++q) outp[(size_t)m * 1024 + q * 64 + F.lane] = v[q] * rstd * gf[q * 64 + F.lane]; }
        return; }
#endif
    STAMP(6);
    if (IN(6)) REP(6) { if (rep_) xcd_barrier(bar);
        LAS float* rs = (LAS float*)(F.lds + 0);
        LAS float* part = (LAS float*)(F.lds + 1024);
        LAS float* lgt = (LAS float*)(F.lds + 1024 + 98304);
        LAS int* hl = (LAS int*)(F.lds + MISC_OFF + 128);
        const bf16_t* WRH = (const bf16_t*)(misc + MS_WR); const bf16_t* WRL = WRH + 48 * 1024;
        const float* gmo = ARG(g_moe); const float* bgr = ARG(b_group); const float* bex = ARG(b_expert);
        if (F.tid < 32) hl[F.tid] = 0;
        for (int tb = (int)blockIdx.x; tb < M / 64; tb += F.G) {
            __syncthreads();
            for (int rr = 0; rr < 8; ++rr) {
                const int tok = tb * 64 + F.wave * 8 + rr;
                const GAS f32x4* xr = (const GAS f32x4*)(X1 + (size_t)tok * DM) + F.lane; f32x4 hv[4]; float ss = 0.f;
#pragma unroll
                for (int j = 0; j < 4; ++j) { hv[j] = xr[64 * j]; ss += (hv[j].x * hv[j].x + hv[j].y * hv[j].y) + (hv[j].z * hv[j].z + hv[j].w * hv[j].w); }
                const float rstd = 1.0f / sqrtf(wave_sum(ss) * (1.f / DM) + EPS);
                if (F.lane == 0) rs[F.wave * 8 + rr] = rstd;
                GAS unsigned long long* o8 = (GAS unsigned long long*)(H2 + (size_t)tok * DM) + F.lane;
#pragma unroll
                for (int j = 0; j < 4; ++j) { const f32x4 g = *((const GAS f32x4*)gmo + 64 * j + F.lane); const f32x4 h_ = hv[j] * rstd * g;
                    o8[64 * j] = (unsigned long long)pk2(h_.x, h_.y) | ((unsigned long long)pk2(h_.z, h_.w) << 32); }
            }
            __syncthreads();
            {
                const int fr = F.lane & 15, fq = F.lane >> 4, kw = 128 * F.wave;
                bf16x8 bh[3][4], bl[3][4];
#pragma unroll
                for (int n = 0; n < 3; ++n)
#pragma unroll
                    for (int ks = 0; ks < 4; ++ks) { const size_t o_ = (size_t)(16 * n + fr) * 1024 + kw + 32 * ks + 8 * fq; bh[n][ks] = *(const bf16x8*)(WRH + o_); bl[n][ks] = *(const bf16x8*)(WRL + o_); }
                f32x4 gk[4][2];
#pragma unroll
                for (int ks = 0; ks < 4; ++ks) { gk[ks][0] = *(const f32x4*)(gmo + kw + 32 * ks + 8 * fq); gk[ks][1] = *(const f32x4*)(gmo + kw + 32 * ks + 8 * fq + 4); }
#pragma unroll
                for (int m = 0; m < 4; ++m) {
                    f32x4 acc[3]; acc[0] = (f32x4){0.f, 0.f, 0.f, 0.f}; acc[1] = acc[0]; acc[2] = acc[0];
                    const int row = 16 * m + fr; const float rstd = rs[row];
                    const float* xp = X1 + (size_t)(tb * 64 + row) * DM + kw + 8 * fq;
#pragma unroll
                    for (int ks = 0; ks < 4; ++ks) {
                        const f32x4 x0 = *(const f32x4*)(xp + 32 * ks) * rstd * gk[ks][0], x1v = *(const f32x4*)(xp + 32 * ks + 4) * rstd * gk[ks][1];
                        float xv[8] = {x0.x, x0.y, x0.z, x0.w, x1v.x, x1v.y, x1v.z, x1v.w}; u32x4 ah, al;
                        unsigned hw[4], lw[4];
#pragma unroll
                        for (int q = 0; q < 4; ++q) { const unsigned h0 = f2bf(xv[2 * q]), h1 = f2bf(xv[2 * q + 1]); hw[q] = h0 | (h1 << 16);
                            lw[q] = pk2(xv[2 * q] - __builtin_bit_cast(float, h0 << 16), xv[2 * q + 1] - __builtin_bit_cast(float, h1 << 16)); }
                        ah = (u32x4){hw[0], hw[1], hw[2], hw[3]}; al = (u32x4){lw[0], lw[1], lw[2], lw[3]};
                        const bf16x8 ahv = __builtin_bit_cast(bf16x8, ah), alv = __builtin_bit_cast(bf16x8, al);
#pragma unroll
                        for (int n = 0; n < 3; ++n) {
                            acc[n] = __builtin_amdgcn_mfma_f32_16x16x32_bf16(ahv, bh[n][ks], acc[n], 0, 0, 0);
                            acc[n] = __builtin_amdgcn_mfma_f32_16x16x32_bf16(ahv, bl[n][ks], acc[n], 0, 0, 0);
                            acc[n] = __builtin_amdgcn_mfma_f32_16x16x32_bf16(alv, bh[n][ks], acc[n], 0, 0, 0); }
                    }
#pragma unroll
                    for (int n = 0; n < 3; ++n)
#pragma unroll
                        for (int q = 0; q < 4; ++q) part[((F.wave * 48) + (m * 3 + n) * 4 + q) * 64 + F.lane] = acc[n][q];
                }
            }
            __syncthreads();
            for (int e = F.tid; e < 48 * 64; e += 512) { float v = 0.f;
#pragma unroll
                for (int w = 0; w < 8; ++w) v += part[(w * 48) * 64 + e];
                const int l_ = e & 63, q = (e >> 6) & 3, mn = e >> 8, m = mn / 3, n = mn % 3; const int row = 16 * m + 4 * (l_ >> 4) + q, col = 16 * n + (l_ & 15);
                if (col < 36) lgt[row * 40 + col] = v; }
            __syncthreads();
            if (F.tid < 64) {
                const LAS float* lg = lgt + F.tid * 40;
                float gl[4];
#pragma unroll
                for (int g = 0; g < 4; ++g) gl[g] = lg[g] + bgr[g];
                int gi = 0; float gm = gl[0];
#pragma unroll
                for (int g = 1; g < 4; ++g) if (gl[g] > gm) { gm = gl[g]; gi = g; }
                float gs = 0.f;
#pragma unroll
                for (int g = 0; g < 4; ++g) gs += expf(gl[g] - gm);
                const float g_w = 1.0f / gs;
                float el[8];
#pragma unroll
                for (int j = 0; j < 8; ++j) el[j] = lg[4 + gi * 8 + j] + bex[gi * 8 + j];
                int i1 = 0; float m1 = el[0];
#pragma unroll
                for (int j = 1; j < 8; ++j) if (el[j] > m1) { m1 = el[j]; i1 = j; }
                int i2 = 0; float m2 = -__builtin_inff();
#pragma unroll
                for (int j = 0; j < 8; ++j) if (j != i1 && el[j] > m2) { m2 = el[j]; i2 = j; }
                const float e2 = expf(m2 - m1), den = 1.0f / (1.0f + e2);
                const int tok = tb * 64 + F.tid;
#pragma unroll
                for (int k = 0; k < 2; ++k) { const int e = gi * 8 + (k == 0 ? i1 : i2); const float w_ = g_w * (k == 0 ? den : e2 * den);
                    const int rank = __hip_atomic_fetch_add(&hl[e], 1, __ATOMIC_RELAXED, __HIP_MEMORY_SCOPE_WORKGROUP);
                    ASG_E[tok * 2 + k] = e; ASG_W[tok * 2 + k] = w_; ASG_R[tok * 2 + k] = rank; }
            }
            __syncthreads();
            if (F.tid < 32) { HIST[tb * 32 + F.tid] = hl[F.tid]; hl[F.tid] = 0; }
        }
    }
    SEAM(6);

    STAMP(7);
    if (IN(7)) REP(7) { if (rep_) xcd_barrier(bar);
        LAS int* tot = (LAS int*)(F.lds + 0); LAS int* bef = tot + 32; LAS int* pst = tot + 64; LAS int* cumt = tot + 96;
        for (int tb = (int)blockIdx.x; tb < M / 64; tb += F.G) {
            __syncthreads();
            if (F.tid < 32) { int t_ = 0, b_ = 0; for (int q = 0; q < M / 64; ++q) { const int v = HIST[q * 32 + F.tid]; if (q < tb) b_ += v; t_ += v; } tot[F.tid] = t_; bef[F.tid] = b_; }
            __syncthreads();
            if (F.tid == 0) { int run = 0; for (int e = 0; e < 32; ++e) { pst[e] = run; run += (tot[e] + 255) & ~255; cumt[e] = run >> 8; } }
            __syncthreads();
            if (F.tid < 128) { const int tok = tb * 64 + (F.tid >> 1), k = F.tid & 1; const int e = ASG_E[tok * 2 + k]; const int pos = pst[e] + bef[e] + ASG_R[tok * 2 + k];
                ROW_TOK[pos] = tok; ROW_DST[pos] = tok * 2 + k; ROW_W[pos] = ASG_W[tok * 2 + k]; }
            if (tb < 32) { const int e = tb; const int p0 = pst[e] + tot[e], p1 = pst[e] + ((tot[e] + 255) & ~255);
                for (int p = p0 + F.tid; p < p1; p += 512) { ROW_TOK[p] = 0; ROW_DST[p] = -1; ROW_W[p] = 0.f; }
                const int t0 = pst[e] >> 8, t1 = cumt[e];
                for (int t_ = t0 + F.tid; t_ < t1; t_ += 512) TILE_E[t_] = e;
                if (e == 31 && F.tid == 0) TILE_E[255] = cumt[31]; }
        }
    }
    SEAM(7);

    STAMP(8);
    if (IN(8)) REP(8) { if (rep_) xcd_barrier(bar);
        PolUp P; P.K = DM; P.H2 = H2; P.Wup = Wup; P.H = HB; P.row_tok = ROW_TOK; P.tile_e = TILE_E; P.ntiles = TILE_E[255]; P.G = F.G; P.c = F.vcu;
        pg8::gemm_run(F.lds + RING_OFF, P);
    }
    SEAM(8);

    STAMP(9);
    if (IN(9)) REP(9) { if (rep_) xcd_barrier(bar);
        PolDown P; P.K = DEXP; P.Hb = HB; P.Wdn = Wdn; P.Yexp = YEXP; P.row_dst = ROW_DST; P.row_w = ROW_W; P.tile_e = TILE_E; P.ntiles = TILE_E[255]; P.G = F.G; P.c = F.vcu;
        pg8::gemm_run(F.lds + RING_OFF, P);
    }
    SEAM(9);

    DBG_DUMP(9, BF(YEXP[(size_t)(2 * m) * 1024 + c]) + BF(YEXP[(size_t)(2 * m + 1) * 1024 + c]))
    STAMP(10);
    if (IN(10)) REP(10) { if (rep_) xcd_barrier(bar);
        for (int m = gw; m < M; m += NGW) {
            const GAS f32x4* xr = (const GAS f32x4*)(X1 + (size_t)m * DM) + F.lane;
            const GAS u32x2* y0 = (const GAS u32x2*)(YEXP + (size_t)(2 * m) * DM) + F.lane; const GAS u32x2* y1 = (const GAS u32x2*)(YEXP + (size_t)(2 * m + 1) * DM) + F.lane;
            f32x4 v[4]; float s = 0.f;
#pragma unroll
            for (int j = 0; j < 4; ++j) { const u32x2 a = y0[64 * j], c = y1[64 * j]; f32x4 mo; mo.x = bf_lo(a.x) + bf_lo(c.x); mo.y = bf_hi(a.x) + bf_hi(c.x); mo.z = bf_lo(a.y) + bf_lo(c.y); mo.w = bf_hi(a.y) + bf_hi(c.y);
                v[j] = xr[64 * j] + mo; s += (v[j].x * v[j].x + v[j].y * v[j].y) + (v[j].z * v[j].z + v[j].w * v[j].w); }
            const float rstd = 1.0f / sqrtf(wave_sum(s) * (1.f / DM) + EPS);
            GAS f32x4* o = (GAS f32x4*)(ARG(out) + (size_t)m * DM) + F.lane;
#pragma unroll
            for (int j = 0; j < 4; ++j) { const f32x4 g = *((const GAS f32x4*)ARG(g_final) + 64 * j + F.lane); f32x4 ov = v[j] * rstd * g;
#if defined(DBG_TA)
                ov = ov + 10.0f * 0.01f * (float)(tB1 - tB0); if (m == 0 && j == 0 && F.lane == 0) ov.x = 1e4f * 0.01f * (float)(tA1 - tA0);
#endif
                o[64 * j] = ov; }
        }
    }
#undef IN
#undef SEAM
}

extern "C" void kernel_launch(void* const* d_in, const int* in_sizes, int n_in, void* d_out, int out_size, void* d_ws, size_t ws_size, hipStream_t stream) {
    static int grid = 0;
    if (grid == 0) {
        if (n_in != 22 || in_sizes[0] != M * DM || out_size != M * DM || ws_size < WS_END) { fprintf(stderr, "kernel_launch: unexpected shapes (n_in %d, in0 %d, out %d, ws %zu); nothing launched\n", n_in, n_in > 0 ? in_sizes[0] : -1, out_size, ws_size); grid = -1; return; }
        int dev = 0, cus = 0, per_cu = 0;
        if (hipGetDevice(&dev) != hipSuccess || hipDeviceGetAttribute(&cus, hipDeviceAttributeMultiprocessorCount, dev) != hipSuccess) { grid = -1; return; }
        if (hipFuncSetAttribute((const void*)mk_fwd, hipFuncAttributeMaxDynamicSharedMemorySize, LDS_BYTES) != hipSuccess) { fprintf(stderr, "kernel_launch: hipFuncSetAttribute failed\n"); grid = -1; return; }
        if (hipOccupancyMaxActiveBlocksPerMultiprocessor(&per_cu, (const void*)mk_fwd, NWAVES * 64, LDS_BYTES) != hipSuccess || per_cu < 1) fprintf(stderr, "kernel_launch: occupancy query reports %d\n", per_cu);
        (void)hipGetLastError();
        grid = cus;
    }
    if (grid < 0) return;
    if (hipMemsetAsync((char*)d_ws + WS_CTL, 0, CTL_ZERO_BYTES, stream) != hipSuccess) return;
    Args a{};
    a.x = (const float*)d_in[0]; a.g_mix = (const float*)d_in[1]; a.w_in = (const float*)d_in[2]; a.b_fgate = (const float*)d_in[3]; a.b_gate = (const float*)d_in[4];
    a.lq1 = (const float*)d_in[5]; a.lk1 = (const float*)d_in[6]; a.lq2 = (const float*)d_in[7]; a.lk2 = (const float*)d_in[8]; a.g_subln = (const float*)d_in[9];
    a.w_pa = (const float*)d_in[10]; a.w_pb = (const float*)d_in[11]; a.w_o = (const float*)d_in[12]; a.g_moe = (const float*)d_in[13]; a.w_group = (const float*)d_in[14]; a.b_group = (const float*)d_in[15];
    a.w_expert = (const float*)d_in[16]; a.b_expert = (const float*)d_in[17]; a.w1 = (const float*)d_in[18]; a.w3 = (const float*)d_in[19]; a.w2 = (const float*)d_in[20]; a.g_final = (const float*)d_in[21];
    a.out = (float*)d_out; a.ws = (unsigned char*)d_ws;
    if (MK_N_LAUNCHES == 1) { a.ph_lo = 0; a.ph_hi = NPH; hipLaunchKernelGGL(mk_fwd, dim3(grid), dim3(NWAVES * 64), LDS_BYTES, stream, a); }
    else for (int p = 0; p < NPH; ++p) { a.ph_lo = p; a.ph_hi = p + 1; hipLaunchKernelGGL(mk_fwd, dim3(grid), dim3(NWAVES * 64), LDS_BYTES, stream, a); }
}
```
